# Optimizing an MI355X kernel written in HIP

```python
import jax, jax.numpy as jnp
from jax import lax
import numpy as np

D_MODEL = 1024
BATCH = 8
SEQ = 4096
DEPTH = 2

GRID_W = 64
CTX_LEN = 256
N_MIXERS = 2
N_HEADS = 8
N_KV_HEADS = 2
HEAD_DIM = 128
KV_GROUP = N_HEADS // N_KV_HEADS
ROPE_THETA = 10000.0
Q_BLOCK = 128
CONV_WIDTH = 3
N_EXPERTS = 256
TOP_K = 8
N_GROUPS = 8
TOPK_GROUPS = 4
EXPERT_FF = 256
SHARED_FF = 256
ROUTED_SCALE = 2.5
MOE_BLOCK = 128
LN_EPS = 1e-5
QK_EPS = 1e-6
DN_ALPHA = (2 * DEPTH) ** 0.25
DN_BETA = (8 * DEPTH) ** -0.25

kernel_name = "hybrid_gqa_shortconv_moe_dit"


def layer_norm(x, g, b):
    xf = x.astype(jnp.float32)
    mu = xf.mean(-1, keepdims=True)
    var = jnp.square(xf - mu).mean(-1, keepdims=True)
    return ((xf - mu) * lax.rsqrt(var + LN_EPS)).astype(x.dtype) * g + b


def rms_norm(x, g):
    xf = x.astype(jnp.float32)
    return (xf * lax.rsqrt(jnp.mean(xf * xf, -1, keepdims=True) + QK_EPS)).astype(x.dtype) * g


def axial_rope_angles(n_tok):
    rows = n_tok // GRID_W
    row = jnp.repeat(jnp.arange(rows, dtype=jnp.float32), GRID_W)
    col = jnp.tile(jnp.arange(GRID_W, dtype=jnp.float32), rows)
    axis_dim = HEAD_DIM // 2
    freqs = ROPE_THETA ** (-jnp.arange(0, axis_dim, 2, dtype=jnp.float32) / axis_dim)
    return jnp.concatenate([row[:, None] * freqs, col[:, None] * freqs], axis=-1)


def apply_rope(x, ang):
    xf = x.astype(jnp.float32).reshape(*x.shape[:-1], HEAD_DIM // 2, 2)
    cos = jnp.cos(ang)[None, :, None, :]
    sin = jnp.sin(ang)[None, :, None, :]
    x0, x1 = xf[..., 0], xf[..., 1]
    out = jnp.stack([x0 * cos - x1 * sin, x0 * sin + x1 * cos], axis=-1)
    return out.reshape(x.shape).astype(x.dtype)


def gqa(q, k, v):
    b, sq = q.shape[:2]
    qg = q.reshape(b, sq, N_KV_HEADS, KV_GROUP, HEAD_DIM)
    s = jnp.einsum('bqkgd,bskd->bkgqs', qg, k) * (HEAD_DIM ** -0.5)
    p = jax.nn.softmax(s.astype(jnp.float32), axis=-1).astype(v.dtype)
    o = jnp.einsum('bkgqs,bskd->bqkgd', p, v)
    return o.reshape(b, sq, N_HEADS * HEAD_DIM)


def attention_mixer(hx, hc, w_qkv, q_g, k_g, w_o, ctx_out):
    hq = N_HEADS * HEAD_DIM
    kd = N_KV_HEADS * HEAD_DIM

    def kv_heads(kv):
        k = kv[..., :kd].reshape(*kv.shape[:2], N_KV_HEADS, HEAD_DIM)
        v = kv[..., kd:].reshape(*kv.shape[:2], N_KV_HEADS, HEAD_DIM)
        return rms_norm(k, k_g), v

    qkv = hx @ w_qkv
    qx = rms_norm(qkv[..., :hq].reshape(*hx.shape[:2], N_HEADS, HEAD_DIM), q_g)
    kx, vx = kv_heads(qkv[..., hq:])
    ang = axial_rope_angles(hx.shape[1])
    qx, kx = apply_rope(qx, ang), apply_rope(kx, ang)
    if ctx_out:
        qkv_c = hc @ w_qkv
        qc = rms_norm(qkv_c[..., :hq].reshape(*hc.shape[:2], N_HEADS, HEAD_DIM), q_g)
        kc, vc = kv_heads(qkv_c[..., hq:])
    else:
        kc, vc = kv_heads(hc @ w_qkv[:, hq:])
    k_all = jnp.concatenate([kc, kx], axis=1)
    v_all = jnp.concatenate([vc, vx], axis=1)
    b, n = hx.shape[:2]
    nb = n // Q_BLOCK
    q_blocks = qx.reshape(b, nb, Q_BLOCK, N_HEADS, HEAD_DIM).transpose(1, 0, 2, 3, 4)
    o = lax.map(lambda qb: gqa(qb, k_all, v_all), q_blocks)
    yx = o.transpose(1, 0, 2, 3).reshape(b, n, hq) @ w_o
    yc = gqa(qc, kc, vc) @ w_o if ctx_out else None
    return yx, yc


def short_conv_mixer(hx, hc, w_in, taps, w_out, ctx_out):
    pad = CONV_WIDTH // 2

    def mix(h):
        n = h.shape[1]
        bg, cg, v = jnp.split(h @ w_in, 3, axis=-1)
        u = jnp.pad(cg * v, ((0, 0), (pad, pad), (0, 0)))
        conv = sum(u[:, j:j + n] * taps[j] for j in range(CONV_WIDTH))
        return (bg * conv) @ w_out

    return mix(hx), (mix(hc) if ctx_out else None)


def moe_ffn(h, router_w, router_bias, w_gate_up, w_down, sw_gate_up, sw_down):
    t, d = h.shape
    scores = jax.nn.sigmoid((h @ router_w).astype(jnp.float32))
    biased = scores + router_bias.astype(jnp.float32)
    per_group = N_EXPERTS // N_GROUPS
    grp_score = lax.top_k(biased.reshape(t, N_GROUPS, per_group), 2)[0].sum(-1)
    _, top_grp = lax.top_k(grp_score, TOPK_GROUPS)
    grp_mask = jnp.any(top_grp[:, :, None] == jnp.arange(N_GROUPS)[None, None, :], axis=1)
    masked = jnp.where(jnp.repeat(grp_mask, per_group, axis=1), biased, -jnp.inf)
    _, eidx = lax.top_k(masked, TOP_K)
    gates = jnp.take_along_axis(scores, eidx, axis=1)
    gates = (gates / gates.sum(-1, keepdims=True) * ROUTED_SCALE).astype(h.dtype)

    tk = t * TOP_K
    eid = eidx.reshape(tk)
    tok = jnp.repeat(jnp.arange(t, dtype=jnp.int32), TOP_K)
    gw = gates.reshape(tk)
    order = jnp.argsort(eid)
    e_s, tok_s, gw_s = eid[order], tok[order], gw[order]
    counts = jnp.bincount(eid, length=N_EXPERTS)
    starts = jnp.cumsum(counts) - counts
    pcounts = (counts + MOE_BLOCK - 1) // MOE_BLOCK * MOE_BLOCK
    pends = jnp.cumsum(pcounts)
    pstarts = pends - pcounts
    dest = pstarts[e_s] + jnp.arange(tk, dtype=jnp.int32) - starts[e_s]
    n_blk = (tk + N_EXPERTS * (MOE_BLOCK - 1) + MOE_BLOCK - 1) // MOE_BLOCK
    p = n_blk * MOE_BLOCK
    buf_tok = jnp.full((p,), t, jnp.int32).at[dest].set(tok_s)
    buf_w = jnp.zeros((p,), h.dtype).at[dest].set(gw_s)
    blk_e = jnp.minimum(jnp.searchsorted(pends, jnp.arange(n_blk, dtype=jnp.int32) * MOE_BLOCK,
                                         side='right'), N_EXPERTS - 1)
    h_pad = jnp.concatenate([h, jnp.zeros((1, d), h.dtype)], axis=0)

    def expert_block(acc, xs):
        tb, wb, e = xs
        g, u = jnp.split(h_pad[tb] @ w_gate_up[e], 2, axis=-1)
        yb = (jax.nn.silu(g) * u) @ w_down[e]
        return acc.at[tb].add(yb * wb[:, None]), None

    routed, _ = lax.scan(expert_block, jnp.zeros_like(h_pad),
                         (buf_tok.reshape(n_blk, MOE_BLOCK), buf_w.reshape(n_blk, MOE_BLOCK), blk_e))
    sg, su = jnp.split(h @ sw_gate_up, 2, axis=-1)
    return (jax.nn.silu(sg) * su) @ sw_down + routed[:t]


def setup_inputs(seed: int = 0) -> dict:
    key = jax.random.key(seed)
    ks = jax.random.split(key, 21)

    def nrm(k, shape, scale):
        return jax.random.normal(k, shape, jnp.float32) * scale

    n_attn = (DEPTH + N_MIXERS - 1) // N_MIXERS
    n_conv = DEPTH // N_MIXERS
    qkv_dim = (N_HEADS + 2 * N_KV_HEADS) * HEAD_DIM
    hq = N_HEADS * HEAD_DIM
    d = D_MODEL
    return {
        "x": nrm(ks[0], (BATCH, SEQ, d), 1.0),
        "c": nrm(ks[1], (BATCH, d), 1.0),
        "ctx": nrm(ks[2], (BATCH, CTX_LEN, d), 1.0),
        "c_ctx": nrm(ks[3], (d,), 1.0),
        "ada_w": nrm(ks[4], (DEPTH, d, 6 * d), 0.5 * d ** -0.5),
        "ada_b": nrm(ks[5], (DEPTH, 6 * d), 0.02),
        "ln_g": 1.0 + nrm(ks[6], (DEPTH, 2, d), 0.02),
        "ln_b": nrm(ks[7], (DEPTH, 2, d), 0.02),
        "attn_w_qkv": nrm(ks[8], (n_attn, d, qkv_dim), d ** -0.5),
        "attn_q_norm": 1.0 + nrm(ks[9], (n_attn, HEAD_DIM), 0.02),
        "attn_k_norm": 1.0 + nrm(ks[10], (n_attn, HEAD_DIM), 0.02),
        "attn_w_o": nrm(ks[11], (n_attn, hq, d), DN_BETA * hq ** -0.5),
        "conv_w_in": nrm(ks[12], (n_conv, d, 3 * d), d ** -0.5),
        "conv_taps": nrm(ks[13], (n_conv, CONV_WIDTH, d), CONV_WIDTH ** -0.5),
        "conv_w_out": nrm(ks[14], (n_conv, d, d), DN_BETA * d ** -0.5),
        "router_w": nrm(ks[15], (DEPTH, d, N_EXPERTS), d ** -0.5),
        "router_bias": nrm(ks[16], (DEPTH, N_EXPERTS), 0.01),
        "exp_w_gate_up": nrm(ks[17], (DEPTH, N_EXPERTS, d, 2 * EXPERT_FF), d ** -0.5),
        "exp_w_down": nrm(ks[18], (DEPTH, N_EXPERTS, EXPERT_FF, d), DN_BETA * EXPERT_FF ** -0.5),
        "shared_w_gate_up": nrm(ks[19], (DEPTH, d, 2 * SHARED_FF), d ** -0.5),
        "shared_w_down": nrm(ks[20], (DEPTH, SHARED_FF, d), DN_BETA * SHARED_FF ** -0.5),
    }


def reference(x, c, ctx, c_ctx, ada_w, ada_b, ln_g, ln_b, attn_w_qkv, attn_q_norm, attn_k_norm,
              attn_w_o, conv_w_in, conv_taps, conv_w_out, router_w, router_bias, exp_w_gate_up,
              exp_w_down, shared_w_gate_up, shared_w_down):
    b, n, d = x.shape
    cl = ctx.shape[1]
    silu_c = jax.nn.silu(c)
    silu_cc = jax.nn.silu(c_ctx)
    for i in range(DEPTH):
        last = i == DEPTH - 1
        is_attn = i % N_MIXERS == 0
        j = i // N_MIXERS
        mx = (silu_c @ ada_w[i] + ada_b[i]).reshape(b, 6, 1, d)
        mc = (silu_cc @ ada_w[i] + ada_b[i]).reshape(6, 1, d)

        hx = x * (1.0 + mx[:, 1]) + mx[:, 0]
        hc = ctx * (1.0 + mc[1]) + mc[0] if (is_attn or not last) else None
        if is_attn:
            yx, yc = attention_mixer(hx, hc, attn_w_qkv[j], attn_q_norm[j], attn_k_norm[j],
                                     attn_w_o[j], not last)
        else:
            yx, yc = short_conv_mixer(hx, hc, conv_w_in[j], conv_taps[j], conv_w_out[j], not last)
        x = layer_norm(DN_ALPHA * x + mx[:, 2] * yx, ln_g[i, 0], ln_b[i, 0])
        if not last:
            ctx = layer_norm(DN_ALPHA * ctx + mc[2] * yc, ln_g[i, 0], ln_b[i, 0])

        hx = (x * (1.0 + mx[:, 4]) + mx[:, 3]).reshape(b * n, d)
        moe_args = (router_w[i], router_bias[i], exp_w_gate_up[i], exp_w_down[i],
                    shared_w_gate_up[i], shared_w_down[i])
        if not last:
            hc = (ctx * (1.0 + mc[4]) + mc[3]).reshape(b * cl, d)
            out = moe_ffn(jnp.concatenate([hc, hx], axis=0), *moe_args)
            ctx = layer_norm(DN_ALPHA * ctx + mc[5] * out[:b * cl].reshape(b, cl, d),
                             ln_g[i, 1], ln_b[i, 1])
            yx = out[b * cl:].reshape(b, n, d)
        else:
            yx = moe_ffn(hx, *moe_args).reshape(b, n, d)
        x = layer_norm(DN_ALPHA * x + mx[:, 5] * yx, ln_g[i, 1], ln_b[i, 1])
    return x
```

```cpp
#include <hip/hip_runtime.h>
#include <cstdio>
#include <cstdint>

#ifndef MK_ONE_LAUNCH
#define MK_ONE_LAUNCH 0
#endif
#ifndef USE_SIMPLE_GEMM
#define USE_SIMPLE_GEMM 0
#endif

#define GAS __attribute__((address_space(1)))
#define LAS __attribute__((address_space(3)))
typedef unsigned short bf16;
typedef short bf16x8 __attribute__((ext_vector_type(8)));
typedef short s16x4 __attribute__((ext_vector_type(4)));
typedef float f32x4 __attribute__((ext_vector_type(4)));
typedef float f32x16 __attribute__((ext_vector_type(16)));
typedef unsigned u32x4 __attribute__((ext_vector_type(4)));
typedef unsigned u32x2 __attribute__((ext_vector_type(2)));

constexpr int NB = 8, SEQ = 4096, CTXL = 256, DM = 1024, RPB = SEQ + CTXL  , MROWS = NB * RPB  ;
constexpr int NH = 8, NKV = 2, HD = 128, NQKV = (NH + 2 * NKV) * HD  , NWIN = 3 * DM;
constexpr int NE = 256, TOPK = 8, EFF = 256;
constexpr int TL0 = MROWS, TL1 = NB * SEQ;
constexpr float LN_EPS = 1e-5f, QK_EPS = 1e-6f, DN_ALPHA = 1.4142135623730951f, ROUTED_SCALE = 2.5f;
constexpr int P_MAX = MROWS * 9 + 65536;

constexpr size_t MiB = 1u << 20;
constexpr size_t WS_CTL = 0, CTL_ZERO_BYTES = 1 * MiB;
constexpr size_t WS_MOD = 1 * MiB;
constexpr size_t WS_ROPE = 2 * MiB;
constexpr size_t WS_WQKV = 4 * MiB;
constexpr size_t WS_WO = 7 * MiB;
constexpr size_t WS_WIN = 9 * MiB;
constexpr size_t WS_WOUT = 15 * MiB;
constexpr size_t WS_WR = 17 * MiB;
constexpr size_t WS_WGU = 18 * MiB;
constexpr size_t WS_WD = 532 * MiB;
constexpr size_t WS_HX = 789 * MiB;
constexpr size_t WS_QKV = 857 * MiB;
constexpr size_t WS_O = 1061 * MiB;
constexpr size_t WS_Y = 1129 * MiB;
constexpr size_t WS_X1 = 1197 * MiB;
constexpr size_t WS_H2 = 1333 * MiB;
constexpr size_t WS_LOG = 1401 * MiB;
constexpr size_t WS_EIDX = 1435 * MiB;
constexpr size_t WS_GATE = 1437 * MiB;
constexpr size_t WS_POS = 1439 * MiB;
constexpr size_t WS_TOK = 1441 * MiB;
constexpr size_t WS_ACT = 1443 * MiB;
constexpr size_t WS_YS = 1628 * MiB;
constexpr size_t WS_X2 = 2368 * MiB;
constexpr size_t WS_END = 2504 * MiB;
static_assert(WS_ACT + (size_t)P_MAX * 256 * 2 <= WS_YS && WS_YS + (size_t)P_MAX * 1024 * 2 <= WS_X2 && WS_X2 + (size_t)MROWS * 1024 * 4 <= WS_END, "ws map");
static_assert(WS_WGU + (size_t)2 * 257 * 512 * 1024 * 2 <= WS_WD && WS_WD + (size_t)2 * 257 * 1024 * 256 * 2 <= WS_HX, "ws map w");
static_assert(WS_QKV + (size_t)MROWS * 3072 * 2 <= WS_O && WS_X1 + (size_t)MROWS * 1024 * 4 <= WS_H2 && WS_LOG + (size_t)MROWS * 256 * 4 <= WS_EIDX, "ws map a");
constexpr int CW_BAR = 4096;
constexpr int CW_CNT = 16384;
constexpr int CW_FILL = 16384 + 1024;

constexpr int RING_BYTES = 131072;
constexpr int MISC_OFF = RING_BYTES;
constexpr int TBL_OFF = RING_BYTES + 512;
constexpr int TBL_TMP = TBL_OFF + 1088, TBL_EXP = TBL_TMP + 1024;
constexpr int LDS_BYTES = 147456;

__device__ __forceinline__ unsigned cvt_pk_bf16(float lo, float hi) { unsigned r; asm volatile("v_cvt_pk_bf16_f32 %0, %1, %2" : "=v"(r) : "v"(lo), "v"(hi)); return r; }
__device__ __forceinline__ float bf_lo(unsigned w) { return __uint_as_float(w << 16); }
__device__ __forceinline__ float bf_hi(unsigned w) { return __uint_as_float(w & 0xffff0000u); }
__device__ __forceinline__ float wave_sum(float v) {
#pragma unroll
    for (int o = 1; o < 64; o <<= 1) v += __shfl_xor(v, o);
    return v;
}
__device__ __forceinline__ float silu_f(float g) { return g * __builtin_amdgcn_rcpf(1.0f + __builtin_amdgcn_exp2f(-1.4426950408889634f * g)); }

#define XB_TMO      128
#define XB_XCNT(j)  (256  + 64 * (j))
#define XB_XSUB(j)  (1280 + 64 * (j))
#define XB_XGEN(j)  (2304 + 64 * (j))
#define XB_TOP      3328
#define XB_TOPGEN   3392
#define XCD_BAR_WORDS 3456
#define XB_SPIN_CAP (1u << 18)

__device__ __forceinline__ unsigned xb_ld(unsigned* p)              { return __hip_atomic_load(p, __ATOMIC_RELAXED, __HIP_MEMORY_SCOPE_AGENT); }
__device__ __forceinline__ unsigned xb_add(unsigned* p, unsigned v) { return __hip_atomic_fetch_add(p, v, __ATOMIC_RELAXED, __HIP_MEMORY_SCOPE_AGENT); }
__device__ __forceinline__ unsigned xb_xcc_id() { return (unsigned)__builtin_amdgcn_s_getreg((3 << 11) | 20) & 0xFu; }
#define XB_SPIN(cond, bar) do { unsigned _sp = 0; while (cond) { __builtin_amdgcn_s_sleep(1); \
    if ((++_sp & 255u) == 0u) { if (xb_ld(&(bar)[XB_TMO])) break; if (_sp > XB_SPIN_CAP) { atomicAdd(&(bar)[XB_TMO], 1u); break; } } } } while (0)

struct XcdBarrier { unsigned* bar; unsigned x; volatile LAS unsigned* st; };

__device__ __forceinline__ XcdBarrier xcd_barrier_post(unsigned* bar, volatile LAS unsigned* st) {
    XcdBarrier b; b.bar = bar; b.x = xb_xcc_id(); b.st = st;
    if (threadIdx.x == 0) (void)xb_add(&bar[XB_XCNT(b.x)], 1u);
    return b;
}
__device__ __forceinline__ void xcd_barrier_complete(unsigned* bar, unsigned x, unsigned& nloc, unsigned& nx) {
    const unsigned G = gridDim.x * gridDim.y * gridDim.z;
    unsigned sum, cnt, mine, sp = 0u;
    for (;;) {
        sum = 0u; cnt = 0u; mine = 0u;
#pragma unroll
        for (unsigned j = 0; j < 16; ++j) { const unsigned c = xb_ld(&bar[XB_XCNT(j)]); sum += c; cnt += (c > 0u) ? 1u : 0u; mine = (j == x) ? c : mine; }
        if (sum == G) break;
        __builtin_amdgcn_s_sleep(1);
        if ((++sp & 255u) == 0u) { if (xb_ld(&bar[XB_TMO])) break; if (sp > XB_SPIN_CAP) { atomicAdd(&bar[XB_TMO], 1u); break; } }
    }
    nloc = mine > 0u ? mine : 1u; nx = cnt > 0u ? cnt : 1u;
}
__device__ __forceinline__ void xcd_barrier(const XcdBarrier& b) {
    asm volatile("s_waitcnt vmcnt(0)" ::: "memory");
    __syncthreads();
    if (threadIdx.x == 0) {
        unsigned* bar = b.bar;
        __builtin_amdgcn_s_waitcnt(0);
        unsigned nloc = b.st[0], nx = b.st[1];
        if (nloc == 0u) { xcd_barrier_complete(bar, b.x, nloc, nx); b.st[0] = nloc; b.st[1] = nx; }
        const unsigned old = xb_add(&bar[XB_XSUB(b.x)], 1u);
        const unsigned gen = old / nloc;
        if (old + 1u == (gen + 1u) * nloc) {
            __builtin_amdgcn_fence(__ATOMIC_RELEASE, "agent");
            asm volatile("s_waitcnt vmcnt(0)" ::: "memory");
            const unsigned og = xb_add(&bar[XB_TOP], 1u);
            const unsigned tg = og / nx;
            if (og + 1u == (tg + 1u) * nx) xb_add(&bar[XB_TOPGEN], 1u);
            else XB_SPIN(xb_ld(&bar[XB_TOPGEN]) == tg, bar);
            __builtin_amdgcn_fence(__ATOMIC_ACQUIRE, "agent");
            xb_add(&bar[XB_XGEN(b.x)], 1u);
            asm volatile("s_waitcnt vmcnt(0)" ::: "memory");
        } else {
            XB_SPIN(xb_ld(&bar[XB_XGEN(b.x)]) == gen, bar);
            __builtin_amdgcn_fence(__ATOMIC_ACQUIRE, "agent");
            asm volatile("s_waitcnt vmcnt(0)" ::: "memory");
        }
    }
    __syncthreads();
}

namespace pg8 {
constexpr int BM = 256, BK = 64, HALF = 128, HTB = HALF * BK * 2, STAGE_BYTES = 8 * HTB;
__host__ __device__ __forceinline__ int lds_byte(int r, int c) { const int st = (r >> 4) * 2 + (c >> 5), rr = r & 15, cc = c & 31, ob = rr * 64 + cc * 2; return st * 1024 + (ob ^ (((ob >> 9) & 1) << 5)); }
__host__ __device__ __forceinline__ void stage_rc(int b, int& R, int& C) { const int st = b / 1024, sb = b % 1024, swz = sb ^ (((sb >> 9) & 1) << 5); R = (st >> 1) * 16 + swz / 64; C = (st & 1) * 32 + (swz % 64) / 2; }
__host__ __device__ __forceinline__ int perm32(int rho) { const int n = rho >> 4, i = rho & 15; return 8 * (i >> 2) + 4 * n + (i & 3); }

struct Unit { int rt, pn, ex; };

struct EpiBf16 {
    bf16* O; int ldc;
    __device__ __forceinline__ void operator()(const f32x4 (&acc)[2][2][4][2], const Unit& u, int wr, int wc, int fr, int fq) const {
        const int row0 = u.rt * BM + wr * 64 + fr, col0 = u.pn * BM + wc * 32 + 8 * fq;
#pragma unroll
        for (int ai = 0; ai < 2; ++ai)
#pragma unroll
            for (int m = 0; m < 4; ++m) { bf16* rowp = O + (size_t)(row0 + ai * HALF + m * 16) * ldc + col0;
#pragma unroll
                for (int bj = 0; bj < 2; ++bj) { const f32x4 v0 = acc[ai][bj][m][0], v1 = acc[ai][bj][m][1];
                    u32x4 w; w.x = cvt_pk_bf16(v0[0], v0[1]); w.y = cvt_pk_bf16(v0[2], v0[3]); w.z = cvt_pk_bf16(v1[0], v1[1]); w.w = cvt_pk_bf16(v1[2], v1[3]);
                    *(u32x4*)(rowp + bj * HALF) = w; } }
    }
};
struct EpiF32 {
    float* C; int ldc;
    __device__ __forceinline__ void operator()(const f32x4 (&acc)[2][2][4][2], const Unit& u, int wr, int wc, int fr, int fq) const {
        const int row0 = u.rt * BM + wr * 64 + fr, col0 = u.pn * BM + wc * 32 + 8 * fq;
#pragma unroll
        for (int ai = 0; ai < 2; ++ai)
#pragma unroll
            for (int m = 0; m < 4; ++m) { float* rowp = C + (size_t)(row0 + ai * HALF + m * 16) * ldc + col0;
#pragma unroll
                for (int bj = 0; bj < 2; ++bj) { *(f32x4*)(rowp + bj * HALF) = acc[ai][bj][m][0]; *(f32x4*)(rowp + bj * HALF + 4) = acc[ai][bj][m][1]; } }
    }
};
struct EpiSwiGLU {
    bf16* O;
    __device__ __forceinline__ void operator()(const f32x4 (&acc)[2][2][4][2], const Unit& u, int wr, int wc, int fr, int fq) const {
        const int row0 = u.rt * BM + wr * 64 + fr, col0 = u.pn * HALF + wc * 32 + 8 * fq;
#pragma unroll
        for (int ai = 0; ai < 2; ++ai)
#pragma unroll
            for (int m = 0; m < 4; ++m) { bf16* rowp = O + (size_t)(row0 + ai * HALF + m * 16) * EFF + col0;
                float r[8];
#pragma unroll
                for (int n = 0; n < 2; ++n)
#pragma unroll
                    for (int j = 0; j < 4; ++j) r[n * 4 + j] = silu_f(acc[ai][0][m][n][j]) * acc[ai][1][m][n][j];
                u32x4 w; w.x = cvt_pk_bf16(r[0], r[1]); w.y = cvt_pk_bf16(r[2], r[3]); w.z = cvt_pk_bf16(r[4], r[5]); w.w = cvt_pk_bf16(r[6], r[7]);
                *(u32x4*)rowp = w; }
    }
};

struct DenseOrder {
    int nM, nN, nwg, G, c, latent; const char* A; const char* Bt; size_t tstep;
    __device__ void init(int nM_, int nN_, int G_, int c_, int latent_, const void* A_, const void* Bt_, int K) { nM = nM_; nN = nN_; nwg = nM * nN; G = G_; c = c_; latent = latent_; A = (const char*)A_; Bt = (const char*)Bt_; tstep = (size_t)BM * K * 2; }
    __device__ __forceinline__ bool next(int i, Unit& u) const {
        const long L = (long)i * G + c; if (L >= nwg) return false;
        int wgid = (int)L; { const int q = nwg / 8, r = nwg % 8, xcd = wgid % 8, off = wgid / 8; wgid = (xcd < r ? xcd * (q + 1) : r * (q + 1) + (xcd - r) * q) + off; }
        const int nig = 8 * nN, gid = wgid / nig, fm = gid * 8, gsz = (nM - fm) < 8 ? (nM - fm) : 8;
        const int pm = fm + ((wgid % nig) % gsz); u.pn = (wgid % nig) / gsz; u.ex = 0;
        u.rt = latent ? (pm >> 4) * 17 + 1 + (pm & 15) : pm; return true;
    }
    __device__ __forceinline__ const char* a_base(const Unit& u) const { return A + (size_t)u.rt * tstep; }
    __device__ __forceinline__ const char* b_base(const Unit& u) const { return Bt + (size_t)u.pn * tstep; }
    __device__ __forceinline__ const int* tok(const Unit&) const { return nullptr; }
};
template <int NTN_LOG2>
struct ExpertOrder {
    int nunits, G, c; const LAS unsigned short* texp; const char* A; const char* Bt; const int* toks; unsigned a_tstep, b_tstep;
    __device__ __forceinline__ bool next(int i, Unit& u) const {
        const int L = i * G + c; if (L >= nunits) return false;
        const int tile = L >> NTN_LOG2; u.pn = L & ((1 << NTN_LOG2) - 1); u.rt = tile; u.ex = (int)texp[tile]; return true;
    }
    __device__ __forceinline__ const char* a_base(const Unit& u) const { return A + (size_t)u.rt * a_tstep; }
    __device__ __forceinline__ const char* b_base(const Unit& u) const { return Bt + (size_t)((u.ex << NTN_LOG2) + u.pn) * b_tstep; }
    __device__ __forceinline__ const int* tok(const Unit& u) const { return toks + (size_t)u.rt * BM; }
};

#if !USE_SIMPLE_GEMM
template <class Epi, class Sched, bool GATHER>
__device__ __forceinline__ void gemm_phase(LAS unsigned char* lds, const Sched& S, const Epi& E, const int K, const int tid) {
    const int wid = __builtin_amdgcn_readfirstlane(tid >> 6), lane = tid & 63, wr = wid >> 2, wc = wid & 3, fr = lane & 15, fq = lane >> 4;
    const int nt = K / BK;
    int Rr[2], Cc[2];
    unsigned voffB[2];
#pragma unroll
    for (int i = 0; i < 2; ++i) { int R, C; stage_rc(tid * 16 + i * 8192, R, C); const int Rb = (R & ~31) + perm32(R & 31); Rr[i] = R; Cc[i] = C; voffB[i] = (unsigned)(Rb * K + C) * 2u; }
    const size_t kstep = (size_t)(BK * 2);
    const size_t hstep = (size_t)HALF * K * 2;
    const unsigned ldsw = (unsigned)wid * 1024u;
    const int aoff = lds_byte(wr * 64 + fr, fq * 8), boff = lds_byte(wc * 32 + fr, fq * 8);
#define PG8_SA(b, h) (((b) * 2 + (h)) * HTB)
#define PG8_SB(b, h) ((4 + (b) * 2 + (h)) * HTB)
#define PG8_STAGE2(bufoff, gbase, v0, v1) do { \
        __builtin_amdgcn_global_load_lds((const unsigned*)((const char*)(gbase) + (v0)), (LAS unsigned*)(lds + (bufoff) + ldsw), 16, 0, 0); \
        __builtin_amdgcn_global_load_lds((const unsigned*)((const char*)(gbase) + (v1)), (LAS unsigned*)(lds + (bufoff) + ldsw + 8192), 16, 0, 0); } while (0)
#define PG8_STAGEB(bufoff, gbase) PG8_STAGE2(bufoff, gbase, voffB[0], voffB[1])
#define PG8_LDA(dst, b, h) do { _Pragma("unroll") for (int m = 0; m < 4; ++m) _Pragma("unroll") for (int k = 0; k < 2; ++k) dst[m][k] = *(const LAS bf16x8*)(lds + PG8_SA(b, h) + aoff + m * 2048 + k * 1024); } while (0)
#define PG8_LDB(dst, b, h) do { _Pragma("unroll") for (int n = 0; n < 2; ++n) _Pragma("unroll") for (int k = 0; k < 2; ++k) dst[n][k] = *(const LAS bf16x8*)(lds + PG8_SB(b, h) + boff + n * 2048 + k * 1024); } while (0)
#define PG8_MMA(ai, bj, At, Bt) do { __builtin_amdgcn_s_setprio(1); _Pragma("unroll") for (int m = 0; m < 4; ++m) _Pragma("unroll") for (int n = 0; n < 2; ++n) _Pragma("unroll") for (int k = 0; k < 2; ++k) \
        acc[ai][bj][m][n] = __builtin_amdgcn_mfma_f32_16x16x32_bf16(Bt[n][k], At[m][k], acc[ai][bj][m][n], 0, 0, 0); __builtin_amdgcn_s_setprio(0); } while (0)
#define PG8_WAIT_V(n) asm volatile("s_waitcnt vmcnt(" #n ")" ::: "memory")
#define PG8_WAIT_L(n) asm volatile("s_waitcnt lgkmcnt(" #n ")" ::: "memory")
#define PG8_BAR __builtin_amdgcn_s_barrier()
#define PG8_SCHED __builtin_amdgcn_sched_barrier(0)
    Unit cur, nxt; int ui = 0;
    if (!S.next(0, cur)) return;
    f32x4 acc[2][2][4][2];
#pragma unroll
    for (int a = 0; a < 2; ++a)
#pragma unroll
        for (int b = 0; b < 2; ++b)
#pragma unroll
            for (int m = 0; m < 4; ++m)
#pragma unroll
                for (int n = 0; n < 2; ++n) acc[a][b][m][n] = (f32x4){0.f, 0.f, 0.f, 0.f};
    bf16x8 At[4][2], B0[2][2], B1[2][2];
    unsigned c00, c01, c10, c11, n00, n01, n10, n11;
    if constexpr (GATHER) { const int* tk = S.tok(cur);
        c00 = (unsigned)(tk[Rr[0]] * K + Cc[0]) * 2u; c01 = (unsigned)(tk[Rr[1]] * K + Cc[1]) * 2u; c10 = (unsigned)(tk[HALF + Rr[0]] * K + Cc[0]) * 2u; c11 = (unsigned)(tk[HALF + Rr[1]] * K + Cc[1]) * 2u;
    } else { c00 = (unsigned)(Rr[0] * K + Cc[0]) * 2u; c01 = (unsigned)(Rr[1] * K + Cc[1]) * 2u; c10 = c00 + (unsigned)hstep; c11 = c01 + (unsigned)hstep; }
    n00 = c00; n01 = c01; n10 = c10; n11 = c11;
    const char* cA = S.a_base(cur); const char* cB = S.b_base(cur);
    PG8_STAGEB(PG8_SB(0, 0), cB); PG8_STAGEB(PG8_SB(0, 1), cB + hstep); PG8_STAGE2(PG8_SA(0, 0), cA, c00, c01); PG8_STAGE2(PG8_SA(0, 1), cA, c10, c11);
    if (wr == 1) PG8_BAR;
    PG8_WAIT_V(2); PG8_BAR;
    PG8_STAGEB(PG8_SB(1, 0), cB + kstep); PG8_STAGE2(PG8_SA(1, 0), cA + kstep, c00, c01); PG8_STAGEB(PG8_SB(1, 1), cB + hstep + kstep);
    PG8_WAIT_V(6); PG8_BAR;
    for (;;) {
        const bool has_next = S.next(ui + 1, nxt);
        const char* nA = has_next ? S.a_base(nxt) : cA; const char* nB = has_next ? S.b_base(nxt) : cB;
        if constexpr (GATHER) { if (has_next) { const int* tk = S.tok(nxt);
            n00 = (unsigned)(tk[Rr[0]] * K + Cc[0]) * 2u; n01 = (unsigned)(tk[Rr[1]] * K + Cc[1]) * 2u; n10 = (unsigned)(tk[HALF + Rr[0]] * K + Cc[0]) * 2u; n11 = (unsigned)(tk[HALF + Rr[1]] * K + Cc[1]) * 2u; }
            else { n00 = c00; n01 = c01; n10 = c10; n11 = c11; } }
#pragma nounroll
        for (int t = 0; t < nt; t += 2) {
            const bool last = (t == nt - 2);
            const char* a1 = cA + (size_t)(t + 1) * kstep;
            const char* a2 = last ? nA : cA + (size_t)(t + 2) * kstep; const char* b2 = last ? nB : cB + (size_t)(t + 2) * kstep;
            const char* a3 = a2 + kstep; const char* b3 = b2 + kstep;
            const unsigned s00 = last ? n00 : c00, s01 = last ? n01 : c01, s10 = last ? n10 : c10, s11 = last ? n11 : c11;
            PG8_LDB(B0, 0, 0); PG8_LDB(B1, 0, 1); PG8_SCHED; PG8_LDA(At, 0, 0); PG8_STAGE2(PG8_SA(1, 1), a1, c10, c11);
            PG8_WAIT_V(8); PG8_WAIT_L(0); PG8_BAR; PG8_MMA(0, 0, At, B0); PG8_MMA(0, 1, At, B1); PG8_BAR; PG8_SCHED;
            PG8_LDA(At, 0, 1); PG8_STAGEB(PG8_SB(0, 0), b2); PG8_STAGEB(PG8_SB(0, 1), b2 + hstep); PG8_STAGE2(PG8_SA(0, 0), a2, s00, s01);
            PG8_WAIT_V(8); PG8_WAIT_L(0); PG8_BAR; PG8_MMA(1, 0, At, B0); PG8_MMA(1, 1, At, B1); PG8_BAR; PG8_SCHED;
            PG8_LDB(B0, 1, 0); PG8_LDB(B1, 1, 1); PG8_SCHED; PG8_LDA(At, 1, 0); PG8_STAGE2(PG8_SA(0, 1), a2, s10, s11);
            PG8_WAIT_V(8); PG8_WAIT_L(0); PG8_BAR; PG8_MMA(0, 0, At, B0); PG8_MMA(0, 1, At, B1); PG8_BAR; PG8_SCHED;
            PG8_LDA(At, 1, 1); PG8_STAGEB(PG8_SB(1, 0), b3); PG8_STAGEB(PG8_SB(1, 1), b3 + hstep); PG8_STAGE2(PG8_SA(1, 0), a3, s00, s01);
            PG8_WAIT_V(8); PG8_WAIT_L(0); PG8_BAR; PG8_MMA(1, 0, At, B0); PG8_MMA(1, 1, At, B1); PG8_BAR; PG8_SCHED;
        }
        if (wr == 0) PG8_BAR;
        E(acc, cur, wr, wc, fr, fq);
        if (!has_next) break;
#pragma unroll
        for (int a = 0; a < 2; ++a)
#pragma unroll
            for (int b = 0; b < 2; ++b)
#pragma unroll
                for (int m = 0; m < 4; ++m)
#pragma unroll
                    for (int n = 0; n < 2; ++n) acc[a][b][m][n] = (f32x4){0.f, 0.f, 0.f, 0.f};
        cur = nxt; cA = nA; cB = nB; ++ui; c00 = n00; c01 = n01; c10 = n10; c11 = n11;
        if (wr == 1) PG8_BAR;
    }
    PG8_WAIT_V(0);
    PG8_BAR;
#undef PG8_SA
#undef PG8_SB
#undef PG8_STAGE2
#undef PG8_STAGEB
#undef PG8_LDA
#undef PG8_LDB
#undef PG8_MMA
#undef PG8_WAIT_V
#undef PG8_WAIT_L
#undef PG8_BAR
#undef PG8_SCHED
}
#else
template <class Epi, class Sched, bool GATHER>
__device__ __forceinline__ void gemm_phase(LAS unsigned char*, const Sched& S, const Epi& E, const int K, const int tid) {
    const int wid = __builtin_amdgcn_readfirstlane(tid >> 6), lane = tid & 63, wr = wid >> 2, wc = wid & 3, fr = lane & 15, fq = lane >> 4;
    for (int ui = 0;; ++ui) {
        Unit u; if (!S.next(ui, u)) break;
        f32x4 acc[2][2][4][2];
#pragma unroll
        for (int a = 0; a < 2; ++a)
#pragma unroll
            for (int b = 0; b < 2; ++b)
#pragma unroll
                for (int m = 0; m < 4; ++m)
#pragma unroll
                    for (int n = 0; n < 2; ++n) acc[a][b][m][n] = (f32x4){0.f, 0.f, 0.f, 0.f};
        const char* Ab = S.a_base(u); const char* Bb = S.b_base(u);
        unsigned ao[2][4], bo[2][2];
#pragma unroll
        for (int ai = 0; ai < 2; ++ai)
#pragma unroll
            for (int m = 0; m < 4; ++m) { const int r = ai * HALF + wr * 64 + m * 16 + fr; int rr = r; if constexpr (GATHER) rr = S.tok(u)[r]; ao[ai][m] = (unsigned)(rr * K + fq * 8) * 2u; }
#pragma unroll
        for (int bj = 0; bj < 2; ++bj)
#pragma unroll
            for (int n = 0; n < 2; ++n) { const int r = bj * HALF + wc * 32 + 8 * (fr >> 2) + 4 * n + (fr & 3); bo[bj][n] = (unsigned)(r * K + fq * 8) * 2u; }
        for (int k0 = 0; k0 < K; k0 += 32) {
            bf16x8 Af[2][4], Bf[2][2];
#pragma unroll
            for (int ai = 0; ai < 2; ++ai)
#pragma unroll
                for (int m = 0; m < 4; ++m) Af[ai][m] = *(const bf16x8*)(Ab + ao[ai][m] + k0 * 2);
#pragma unroll
            for (int bj = 0; bj < 2; ++bj)
#pragma unroll
                for (int n = 0; n < 2; ++n) Bf[bj][n] = *(const bf16x8*)(Bb + bo[bj][n] + k0 * 2);
#pragma unroll
            for (int ai = 0; ai < 2; ++ai)
#pragma unroll
                for (int bj = 0; bj < 2; ++bj)
#pragma unroll
                    for (int m = 0; m < 4; ++m)
#pragma unroll
                        for (int n = 0; n < 2; ++n) acc[ai][bj][m][n] = __builtin_amdgcn_mfma_f32_16x16x32_bf16(Bf[bj][n], Af[ai][m], acc[ai][bj][m][n], 0, 0, 0);
        }
        E(acc, u, wr, wc, fr, fq);
    }
}
#endif
}

namespace att {
constexpr int D = 128, NW = 8, QBLK = 32, KVBLK = 64;
constexpr float SCALE = 0.088388347648318440f, THR = 8.f;
#ifndef ATT_SDEPTH
#define ATT_SDEPTH 1
#endif
constexpr int SDEPTH = ATT_SDEPTH;
constexpr int LDQ = NQKV, LDK = NQKV, LDO = DM;
constexpr size_t SHM_V = KVBLK * D * 2, SHM_K = KVBLK * D * 2, SHM_ATTN = 2 * SHM_V + 2 * SHM_K + NW * 64 * 4;
#define KSWZ(row, colB) ((row) * 256 + ((colB) ^ (((row) & 7) << 4)))
#define SBAR() __builtin_amdgcn_sched_barrier(0)
__device__ __forceinline__ int crow(int r, int hi) { return (r & 3) + 8 * (r >> 2) + 4 * hi; }
__device__ __forceinline__ unsigned cvtpk(float lo, float hi) { unsigned r; asm volatile("v_cvt_pk_bf16_f32 %0, %1, %2" : "=v"(r) : "v"(lo), "v"(hi)); return r; }
__device__ __forceinline__ bf16x8 ld8(const bf16* p) { return *reinterpret_cast<const bf16x8*>(p); }

__device__ __forceinline__ void partialSM(f32x16& p0, f32x16& p1, float& m_reg, float& mn, float& alpha) {
  constexpr float C = SCALE * 1.4426950408889634f;
  float pmax = p0[0]; for (int r = 1; r < 16; ++r) pmax = fmaxf(pmax, p0[r]); for (int r = 0; r < 16; ++r) pmax = fmaxf(pmax, p1[r]);
  { auto rr = __builtin_amdgcn_permlane32_swap(__float_as_uint(pmax), __float_as_uint(pmax), false, false);
    pmax = fmaxf(__uint_as_float(rr[0]), __uint_as_float(rr[1])); }
  if (__builtin_expect(__all(pmax - m_reg <= THR / SCALE), 1)) { mn = m_reg; alpha = 1.f; }
  else { mn = fmaxf(m_reg, pmax); alpha = __builtin_amdgcn_exp2f((m_reg - mn) * C); m_reg = mn; }
  float mnC = -mn * C;
  for (int r = 0; r < 16; ++r) p0[r] = fmaf(p0[r], C, mnC); for (int r = 0; r < 16; ++r) p1[r] = fmaf(p1[r], C, mnC);
  for (int r = 0; r < 16; ++r) p0[r] = __builtin_amdgcn_exp2f(p0[r]);
}
__device__ __forceinline__ void finishSM(f32x16& p0, f32x16& p1, float alpha, float& l_reg, bf16x8& pa0, bf16x8& pa1, bf16x8& pa2, bf16x8& pa3) {
  for (int r = 0; r < 16; ++r) p1[r] = __builtin_amdgcn_exp2f(p1[r]);
  float ps = 0; for (int r = 0; r < 16; ++r) ps += p0[r]; for (int r = 0; r < 16; ++r) ps += p1[r];
  { auto rr = __builtin_amdgcn_permlane32_swap(__float_as_uint(ps), __float_as_uint(ps), false, false);
    ps = __uint_as_float(rr[0]) + __uint_as_float(rr[1]); }
  l_reg = l_reg * alpha + ps;
#define PK4(P, BASE, OUT) do { unsigned a0 = cvtpk(P[BASE + 0], P[BASE + 1]), a1 = cvtpk(P[BASE + 2], P[BASE + 3]);   \
    unsigned b0 = cvtpk(P[BASE + 4], P[BASE + 5]), b1 = cvtpk(P[BASE + 6], P[BASE + 7]);                              \
    auto r0 = __builtin_amdgcn_permlane32_swap(a0, b0, false, false); auto r1 = __builtin_amdgcn_permlane32_swap(a1, b1, false, false); \
    u32x4 w = {r0[0], r1[0], r0[1], r1[1]}; OUT = *reinterpret_cast<bf16x8*>(&w); } while (0)
  PK4(p0, 0, pa0); PK4(p0, 8, pa1); PK4(p1, 0, pa2); PK4(p1, 8, pa3);
#undef PK4
}
__device__ __forceinline__ void qkt(f32x16& p0, f32x16& p1, const bf16* Ks, const bf16x8* qr, int r32, int hi) {
  p0 = f32x16{}; p1 = f32x16{};
  for (int d0 = 0; d0 < 8; ++d0) { int cb = (d0 * 16 + hi * 8) * 2;
    bf16x8 b0 = *reinterpret_cast<const bf16x8*>((const char*)Ks + KSWZ(r32, cb));
    bf16x8 b1 = *reinterpret_cast<const bf16x8*>((const char*)Ks + KSWZ(32 + r32, cb));
    p0 = __builtin_amdgcn_mfma_f32_32x32x16_bf16(b0, qr[d0], p0, 0, 0, 0);
    p1 = __builtin_amdgcn_mfma_f32_32x32x16_bf16(b1, qr[d0], p1, 0, 0, 0); }
}
__device__ __forceinline__ int v_st(int k, int c) { const int kk = (k & ~0xC) | ((k & 4) << 1) | ((k & 8) >> 1); return ((kk >> 3) * 4 + (c >> 5)) * 512 + ((kk & 7) * 32 + (c & 31)) * 2; }
__device__ __forceinline__ int v_rd_base(int lane) { return ((lane & 3) << 3) | (((lane >> 2) & 3) << 6) | (((lane >> 4) & 1) << 5) | (((lane >> 5) & 1) << 8); }
constexpr int v_rd_off(int d0, int ks, int half) { return d0 * 512 + ks * 4096 + half * 2048; }
template <int OFF> __device__ __forceinline__ s16x4 tr_read(int vb) {
  s16x4 r; asm volatile("ds_read_b64_tr_b16 %0, %1 offset:%2" : "=&v"(r) : "v"(vb), "i"(OFF) : "memory"); return r;
}
template <int D0> __device__ __forceinline__ void pv_one(f32x16& od, int vb, bf16x8 pa0, bf16x8 pa1, bf16x8 pa2, bf16x8 pa3) {
  const s16x4 l0 = tr_read<v_rd_off(D0, 0, 0)>(vb), h0 = tr_read<v_rd_off(D0, 0, 1)>(vb), l1 = tr_read<v_rd_off(D0, 1, 0)>(vb), h1 = tr_read<v_rd_off(D0, 1, 1)>(vb);
  const s16x4 l2 = tr_read<v_rd_off(D0, 2, 0)>(vb), h2 = tr_read<v_rd_off(D0, 2, 1)>(vb), l3 = tr_read<v_rd_off(D0, 3, 0)>(vb), h3 = tr_read<v_rd_off(D0, 3, 1)>(vb);
  asm volatile("s_waitcnt lgkmcnt(0)" ::: "memory"); SBAR();
#define PK(L, H) (bf16x8){L[0], L[1], L[2], L[3], H[0], H[1], H[2], H[3]}
  od = __builtin_amdgcn_mfma_f32_32x32x16_bf16(pa0, PK(l0, h0), od, 0, 0, 0);
  od = __builtin_amdgcn_mfma_f32_32x32x16_bf16(pa1, PK(l1, h1), od, 0, 0, 0);
  od = __builtin_amdgcn_mfma_f32_32x32x16_bf16(pa2, PK(l2, h2), od, 0, 0, 0);
  od = __builtin_amdgcn_mfma_f32_32x32x16_bf16(pa3, PK(l3, h3), od, 0, 0, 0);
#undef PK
}
__device__ __forceinline__ void pv_d0(f32x16* o, int vb, bf16x8 pa0, bf16x8 pa1, bf16x8 pa2, bf16x8 pa3) {
  pv_one<0>(o[0], vb, pa0, pa1, pa2, pa3); pv_one<1>(o[1], vb, pa0, pa1, pa2, pa3); pv_one<2>(o[2], vb, pa0, pa1, pa2, pa3); pv_one<3>(o[3], vb, pa0, pa1, pa2, pa3);
}

__device__ __forceinline__ void attn_dense_body(const bf16* __restrict__ Qb, const bf16* __restrict__ Kh, const bf16* __restrict__ Vh, bf16* __restrict__ Ob, int seq, char* lds, const int tid) {
  const int wid = tid >> 6, lane = tid & 63, r32 = lane & 31, hi = lane >> 5;
  bf16* V_lds = (bf16*)lds; bf16* K_lds = (bf16*)(lds + 2 * SHM_V);
  float* ws = (float*)(lds + 2 * SHM_V + 2 * SHM_K) + wid * 64; float* li_l = ws; float* al_l = ws + 32;
  float m_reg = -1e30f, l_reg = 0; f32x16 o[4] = {}; bf16x8 qr[8];
  const bf16* Qw = Qb + (long)(wid * QBLK + r32) * LDQ + hi * 8;
#pragma unroll
  for (int d0 = 0; d0 < 8; ++d0) qr[d0] = ld8(Qw + d0 * 16);
  const int sr = tid >> 4, sc = (tid & 15) * 8, vst0 = v_st(sr, sc), vst1 = v_st(32 + sr, sc);
  const int vb0 = (int)(uintptr_t)V_lds + v_rd_base(lane);
  struct { bf16x8 vs0, vs1, ks0, ks1; } sr_[SDEPTH];
#define SLOAD(i, k0) do { sr_[i].vs0 = ld8(&Vh[(long)((k0) + sr) * LDK + sc]); sr_[i].vs1 = ld8(&Vh[(long)((k0) + 32 + sr) * LDK + sc]); \
    sr_[i].ks0 = ld8(&Kh[(long)((k0) + sr) * LDK + sc]); sr_[i].ks1 = ld8(&Kh[(long)((k0) + 32 + sr) * LDK + sc]); } while (0)
#define SWRITE(b, i) do { *(bf16x8*)((char*)V_lds + (b) * SHM_V + vst0) = sr_[i].vs0;          \
    *(bf16x8*)((char*)V_lds + (b) * SHM_V + vst1) = sr_[i].vs1; int kc = sc * 2;               \
    *(bf16x8*)((char*)K_lds + (b) * SHM_K + KSWZ(sr, kc)) = sr_[i].ks0;                       \
    *(bf16x8*)((char*)K_lds + (b) * SHM_K + KSWZ(32 + sr, kc)) = sr_[i].ks1; } while (0)
#define SWAIT() do { if constexpr (SDEPTH == 2) asm volatile("s_waitcnt vmcnt(4)" ::: "memory"); else asm volatile("s_waitcnt vmcnt(0)" ::: "memory"); } while (0)
#define RESC(a) do { if (__any((a) < 1.f)) { if (hi == 0) al_l[r32] = (a); asm volatile("s_waitcnt lgkmcnt(0)" ::: "memory"); \
    for (int d = 0; d < 4; ++d) for (int r = 0; r < 16; ++r) o[d][r] *= al_l[crow(r, hi)]; } } while (0)
  f32x16 pA0, pA1, pB0, pB1; float mnA, mnB, alA, alB; bf16x8 pa0, pa1, pa2, pa3; const int NT = seq / KVBLK;
  constexpr int SE = 0, SO = SDEPTH - 1;
  SLOAD(SE, 0); asm volatile("s_waitcnt vmcnt(0)" ::: "memory"); SWRITE(0, SE); __syncthreads();
  qkt(pA0, pA1, K_lds, qr, r32, hi); partialSM(pA0, pA1, m_reg, mnA, alA);
  SLOAD(SO, KVBLK); if constexpr (SDEPTH == 2) { if (2 < NT) SLOAD(SE, 2 * KVBLK); }
  SWAIT(); SWRITE(1, SO); __syncthreads();
  for (int j = 1; j + 1 < NT; j += 2) {
    SBAR(); qkt(pB0, pB1, (bf16*)((char*)K_lds + SHM_K), qr, r32, hi);
    finishSM(pA0, pA1, alA, l_reg, pa0, pa1, pa2, pa3); SBAR();
    SLOAD(SO, (j + SDEPTH) * KVBLK); SBAR();
    pv_d0(o, vb0, pa0, pa1, pa2, pa3); partialSM(pB0, pB1, m_reg, mnB, alB);
    __syncthreads(); SWAIT(); SWRITE(0, SE);
    RESC(alB); __syncthreads();
    SBAR(); qkt(pA0, pA1, K_lds, qr, r32, hi);
    finishSM(pB0, pB1, alB, l_reg, pa0, pa1, pa2, pa3); SBAR();
    if (SDEPTH == 1 || j + 3 < NT) SLOAD(SE, (j + 1 + SDEPTH) * KVBLK); SBAR();
    pv_d0(o, vb0 + (int)SHM_V, pa0, pa1, pa2, pa3); partialSM(pA0, pA1, m_reg, mnA, alA);
    __syncthreads(); SWAIT(); SWRITE(1, SO);
    RESC(alA); __syncthreads();
  }
  SBAR(); qkt(pB0, pB1, (bf16*)((char*)K_lds + SHM_K), qr, r32, hi);
  finishSM(pA0, pA1, alA, l_reg, pa0, pa1, pa2, pa3); SBAR();
  pv_d0(o, vb0, pa0, pa1, pa2, pa3); partialSM(pB0, pB1, m_reg, mnB, alB);
  __syncthreads(); RESC(alB);
  finishSM(pB0, pB1, alB, l_reg, pa0, pa1, pa2, pa3); SBAR();
  pv_d0(o, vb0 + (int)SHM_V, pa0, pa1, pa2, pa3);
  if (hi == 0) li_l[r32] = l_reg; asm volatile("s_waitcnt lgkmcnt(0)" ::: "memory");
  float rli[16];
#pragma unroll
  for (int r = 0; r < 16; ++r) rli[r] = __builtin_amdgcn_rcpf(li_l[crow(r, hi)]);
  bf16* Ow = Ob + (long)(wid * QBLK) * LDO;
#pragma unroll
  for (int r = 0; r < 16; r += 2) {
#pragma unroll
    for (int d0 = 0; d0 < 4; ++d0) {
      const float a = o[d0][r] * rli[r], b = o[d0][r + 1] * rli[r + 1];
      const float send = (lane & 1) ? a : b; const float recv = __shfl_xor(send, 1);
      const unsigned w = (lane & 1) ? cvtpk(recv, b) : cvtpk(a, recv);
      const int orow = crow(r, hi) + (lane & 1), ocol = d0 * 32 + (r32 & ~1);
      *(unsigned*)(Ow + (long)orow * LDO + ocol) = w; } }
#undef SLOAD
#undef SWRITE
#undef SWAIT
#undef RESC
}
}

struct Args { const float* in[21]; float* out; unsigned char* ws; int ph_lo, ph_hi; };
static_assert(sizeof(Args) == 23 * 8 + 8, "Args has no padding");
template <int OFF> __device__ __forceinline__ unsigned long long karg64() {
    unsigned long long v; const unsigned long long kp = (unsigned long long)__builtin_amdgcn_kernarg_segment_ptr();
    asm volatile("s_load_dwordx2 %0, %1, %2\n\ts_waitcnt lgkmcnt(0)" : "=s"(v) : "s"(kp), "i"(OFF) : "memory"); return v;
}
#define KIN(i) ((const float*)(const GAS float*)karg64<8 * (i)>())
#define KOUT() ((float*)(GAS float*)karg64<168>())
#define KWS() ((unsigned char*)(GAS unsigned char*)karg64<176>())

struct Ctx { int tid, lane, wave, G, vcu, gw, NGW; LAS unsigned char* lds; };

__device__ __forceinline__ void transpose_item(const float* W, int K, int N, bf16* WT, int k0, int n0, int drow0, LAS float* scr, int lane) {
#pragma unroll 8
    for (int i = 0; i < 32; ++i) { const int kk = 2 * i + (lane >> 5); scr[kk * 33 + (lane & 31)] = W[(size_t)(k0 + kk) * N + n0 + (lane & 31)]; }
    asm volatile("s_waitcnt lgkmcnt(0)" ::: "memory");
    const int c = lane & 7;
#pragma unroll
    for (int j = 0; j < 4; ++j) { const int n = (lane >> 3) + 8 * j; const LAS float* s = scr + (8 * c) * 33 + n;
        u32x4 o; o.x = cvt_pk_bf16(s[0 * 33], s[1 * 33]); o.y = cvt_pk_bf16(s[2 * 33], s[3 * 33]); o.z = cvt_pk_bf16(s[4 * 33], s[5 * 33]); o.w = cvt_pk_bf16(s[6 * 33], s[7 * 33]);
        *(u32x4*)(WT + (size_t)(drow0 + n) * K + k0 + 8 * c) = o; }
    asm volatile("s_waitcnt lgkmcnt(0)" ::: "memory");
}
__device__ __forceinline__ int gu_row(int n0) { return ((n0 & 255) >> 7) * 256 + ((n0 >> 8) << 7) + (n0 & 127); }
__device__ __forceinline__ int tok_row(int l, int tt) { return l == 0 ? tt : (tt >> 12) * RPB + CTXL + (tt & 4095); }

__device__ __forceinline__ void ph_prologue(const Ctx& F) {
    unsigned char* ws = KWS();
    float* MOD = (float*)(ws + WS_MOD); float* ROPE = (float*)(ws + WS_ROPE);
    LAS float* sl = (LAS float*)(F.lds);
    LAS float* red = (LAS float*)(F.lds + 40960);
    if ((int)blockIdx.x < 192 || F.G < 192) {
        const float* c_in = KIN(1); const float* cctx_in = KIN(3); const float* ada_w = KIN(4); const float* ada_b = KIN(5);
        for (int i = F.tid; i < 9 * 1024; i += 512) { const int r = i >> 10, k = i & 1023; const float v = r < 8 ? c_in[r * 1024 + k] : cctx_in[k]; sl[i] = v / (1.0f + expf(-v)); }
        __syncthreads();
        for (int grp = blockIdx.x; grp < 192; grp += F.G) {
            const int l = grp / 96, n0 = (grp % 96) * 64;
            const float* W = ada_w + (size_t)l * 1024 * 6144 + n0 + F.lane;
            float acc[9];
#pragma unroll
            for (int r = 0; r < 9; ++r) acc[r] = 0.f;
            const int kb = F.wave * 128;
#pragma unroll 8
            for (int k = 0; k < 128; ++k) { const float w = W[(size_t)(kb + k) * 6144];
#pragma unroll
                for (int r = 0; r < 9; ++r) acc[r] += sl[r * 1024 + kb + k] * w; }
#pragma unroll
            for (int r = 0; r < 9; ++r) red[(F.wave * 9 + r) * 64 + F.lane] = acc[r];
            __syncthreads();
            for (int i = F.tid; i < 576; i += 512) { const int r = i >> 6, ln = i & 63; float s = ada_b[l * 6144 + n0 + ln];
#pragma unroll
                for (int w = 0; w < 8; ++w) s += red[(w * 9 + r) * 64 + ln];
                MOD[(size_t)(l * 9 + r) * 6144 + n0 + ln] = s; }
            __syncthreads();
        }
    }
    __syncthreads();
    for (int idx = blockIdx.x * 512 + F.tid; idx < 4096 * 64; idx += F.G * 512) {
        const int t = idx >> 6, i = idx & 63; const int pos = i < 32 ? (t >> 6) : (t & 63); const int j = i & 31;
        const float freq = powf(10000.0f, -(float)(2 * j) / 64.0f); const float ang = (float)pos * freq;
        ROPE[2 * idx] = cosf(ang); ROPE[2 * idx + 1] = sinf(ang);
    }
    bf16* Wqkv_t = (bf16*)(ws + WS_WQKV); bf16* Wo_t = (bf16*)(ws + WS_WO); bf16* Win_t = (bf16*)(ws + WS_WIN); bf16* Wout_t = (bf16*)(ws + WS_WOUT);
    bf16* Wr_t = (bf16*)(ws + WS_WR); bf16* Wgu_t = (bf16*)(ws + WS_WGU); bf16* Wd_t = (bf16*)(ws + WS_WD);
    LAS float* scr = (LAS float*)(F.lds + F.wave * 16384);
    constexpr int I_QKV = 16 * 48, I_WO = 16 * 32, I_WIN = 16 * 96, I_WOUT = 16 * 32, I_R = 2 * 16 * 8, I_GU = 2 * 256 * 256, I_GUS = 2 * 256, I_D = 2 * 256 * 128, I_DS = 2 * 128;
    constexpr int NITEMS = I_QKV + I_WO + I_WIN + I_WOUT + I_R + I_GU + I_GUS + I_D + I_DS;
    for (int it = F.gw; it < NITEMS; it += F.NGW) {
        int r = it;
        if (r < I_QKV) { const int nblk = 48, kb = r / nblk, nb = r % nblk; transpose_item(KIN(8), 1024, 1536, Wqkv_t, 64 * kb, 32 * nb, 32 * nb, scr, F.lane); continue; } r -= I_QKV;
        if (r < I_WO) { const int nblk = 32, kb = r / nblk, nb = r % nblk; transpose_item(KIN(11), 1024, 1024, Wo_t, 64 * kb, 32 * nb, 32 * nb, scr, F.lane); continue; } r -= I_WO;
        if (r < I_WIN) { const int nblk = 96, kb = r / nblk, nb = r % nblk; transpose_item(KIN(12), 1024, 3072, Win_t, 64 * kb, 32 * nb, 32 * nb, scr, F.lane); continue; } r -= I_WIN;
        if (r < I_WOUT) { const int nblk = 32, kb = r / nblk, nb = r % nblk; transpose_item(KIN(14), 1024, 1024, Wout_t, 64 * kb, 32 * nb, 32 * nb, scr, F.lane); continue; } r -= I_WOUT;
        if (r < I_R) { const int l = r / 128, q = r % 128, kb = q / 8, nb = q % 8; transpose_item(KIN(15) + (size_t)l * 1024 * 256, 1024, 256, Wr_t + (size_t)l * 256 * 1024, 64 * kb, 32 * nb, 32 * nb, scr, F.lane); continue; } r -= I_R;
        if (r < I_GU) { const int mat = r / 256, q = r % 256, kb = q / 16, nb = q % 16, l = mat / 256, e = mat % 256;
            transpose_item(KIN(17) + (size_t)mat * 1024 * 512, 1024, 512, Wgu_t + (size_t)(l * 257 + e) * 512 * 1024, 64 * kb, 32 * nb, gu_row(32 * nb), scr, F.lane); continue; } r -= I_GU;
        if (r < I_GUS) { const int l = r / 256, q = r % 256, kb = q / 16, nb = q % 16;
            transpose_item(KIN(19) + (size_t)l * 1024 * 512, 1024, 512, Wgu_t + (size_t)(l * 257 + 256) * 512 * 1024, 64 * kb, 32 * nb, gu_row(32 * nb), scr, F.lane); continue; } r -= I_GUS;
        if (r < I_D) { const int mat = r / 128, q = r % 128, kb = q / 32, nb = q % 32, l = mat / 256, e = mat % 256;
            transpose_item(KIN(18) + (size_t)mat * 256 * 1024, 256, 1024, Wd_t + (size_t)(l * 257 + e) * 1024 * 256, 64 * kb, 32 * nb, 32 * nb, scr, F.lane); continue; } r -= I_D;
        { const int l = r / 128, q = r % 128, kb = q / 32, nb = q % 32;
            transpose_item(KIN(20) + (size_t)l * 256 * 1024, 256, 1024, Wd_t + (size_t)(l * 257 + 256) * 1024 * 256, 64 * kb, 32 * nb, 32 * nb, scr, F.lane); }
    }
}

__device__ __forceinline__ void ph_modulate0(const Ctx& F) {
    unsigned char* ws = KWS(); const float* MOD = (const float*)(ws + WS_MOD); bf16* HX = (bf16*)(ws + WS_HX);
    const float* x_in = KIN(0); const float* ctx_in = KIN(2);
    for (int m = F.gw; m < MROWS; m += F.NGW) {
        const int b = m / RPB, j = m % RPB;
        const float* src = j < CTXL ? ctx_in + (size_t)(b * CTXL + j) * DM : x_in + (size_t)(b * SEQ + j - CTXL) * DM;
        const float* md = MOD + (size_t)(j < CTXL ? 8 : b) * 6144;
        unsigned long long* o8 = (unsigned long long*)(HX + (size_t)m * DM) + F.lane;
#pragma unroll
        for (int q = 0; q < 4; ++q) { const int c = 4 * F.lane + 256 * q; const f32x4 v = *(const f32x4*)(src + c), sh = *(const f32x4*)(md + c), sc = *(const f32x4*)(md + 1024 + c);
            const f32x4 h = v * (sc + 1.0f) + sh;
            o8[64 * q] = (unsigned long long)cvt_pk_bf16(h[0], h[1]) | ((unsigned long long)cvt_pk_bf16(h[2], h[3]) << 32); }
    }
}

__device__ __forceinline__ void ph_gemm_in(const Ctx& F, int l) {
    unsigned char* ws = KWS();
    const int N = l == 0 ? NQKV : NWIN;
    pg8::DenseOrder S; S.init(l == 0 ? MROWS / 256 : TL1 / 256, N / 256, F.G, (int)blockIdx.x, l, ws + WS_HX, ws + (l == 0 ? WS_WQKV : WS_WIN), DM);
    pg8::EpiBf16 E{(bf16*)(ws + WS_QKV), N};
    pg8::gemm_phase<pg8::EpiBf16, pg8::DenseOrder, false>(F.lds, S, E, DM, F.tid);
}
__device__ __forceinline__ void ph_gemm_out(const Ctx& F, int l) {
    unsigned char* ws = KWS();
    pg8::DenseOrder S; S.init(l == 0 ? MROWS / 256 : TL1 / 256, DM / 256, F.G, (int)blockIdx.x, l, ws + WS_O, ws + (l == 0 ? WS_WO : WS_WOUT), DM);
    pg8::EpiBf16 E{(bf16*)(ws + WS_Y), DM};
    pg8::gemm_phase<pg8::EpiBf16, pg8::DenseOrder, false>(F.lds, S, E, DM, F.tid);
}
__device__ __forceinline__ void ph_router(const Ctx& F, int l) {
    unsigned char* ws = KWS();
    pg8::DenseOrder S; S.init(l == 0 ? MROWS / 256 : TL1 / 256, 1, F.G, (int)blockIdx.x, l, ws + WS_H2, ws + WS_WR + (size_t)l * 256 * 1024 * 2, DM);
    pg8::EpiF32 E{(float*)(ws + WS_LOG), NE};
    pg8::gemm_phase<pg8::EpiF32, pg8::DenseOrder, false>(F.lds, S, E, DM, F.tid);
}

__device__ __forceinline__ void ph_normrope(const Ctx& F) {
    unsigned char* ws = KWS(); const float* ROPE = (const float*)(ws + WS_ROPE); bf16* QKV = (bf16*)(ws + WS_QKV);
    const float* qg = KIN(9); const float* kg = KIN(10);
    const float2 gq = *(const float2*)(qg + 2 * F.lane), gk = *(const float2*)(kg + 2 * F.lane);
    for (int m = F.gw; m < MROWS; m += F.NGW) {
        const int j = m % RPB; const bool lat = j >= CTXL; const int t = j - CTXL;
        float cs = 1.f, sn = 0.f; if (lat) { const float2 r = *(const float2*)(ROPE + 2 * (t * 64 + F.lane)); cs = r.x; sn = r.y; }
        unsigned* row = (unsigned*)(QKV + (size_t)m * NQKV);
#pragma unroll
        for (int hh = 0; hh < NH + NKV; ++hh) {
            const unsigned w = row[hh * 64 + F.lane]; const float v0 = bf_lo(w), v1 = bf_hi(w);
            const float ss = wave_sum(v0 * v0 + v1 * v1);
            const float rs = 1.0f / sqrtf(ss * (1.0f / 128.0f) + QK_EPS);
            const float g0 = hh < NH ? gq.x : gk.x, g1 = hh < NH ? gq.y : gk.y;
            const float a0 = v0 * rs * g0, a1 = v1 * rs * g1;
            row[hh * 64 + F.lane] = cvt_pk_bf16(a0 * cs - a1 * sn, a0 * sn + a1 * cs);
        }
    }
}
__device__ __forceinline__ void ph_conv(const Ctx& F) {
    unsigned char* ws = KWS(); const bf16* QKV = (const bf16*)(ws + WS_QKV); bf16* OB = (bf16*)(ws + WS_O);
    const float* taps = KIN(13);
    for (int tt = F.gw; tt < TL1; tt += F.NGW) {
        const int m = tok_row(1, tt), s = tt & 4095;
        const bf16* r0 = QKV + (size_t)m * NWIN;
        unsigned long long* o8 = (unsigned long long*)(OB + (size_t)m * DM) + F.lane;
#pragma unroll
        for (int q = 0; q < 4; ++q) { const int c = 4 * F.lane + 256 * q;
            const u32x2 bg = *(const u32x2*)(r0 + c);
            f32x4 cv = (f32x4){0.f, 0.f, 0.f, 0.f};
#pragma unroll
            for (int d = -1; d <= 1; ++d) { if (s + d < 0 || s + d >= SEQ) continue;
                const bf16* rr = r0 + (long)d * NWIN; const u32x2 cg = *(const u32x2*)(rr + DM + c), vv = *(const u32x2*)(rr + 2 * DM + c);
                const f32x4 tp = *(const f32x4*)(taps + (d + 1) * DM + c);
                cv[0] += bf_lo(cg.x) * bf_lo(vv.x) * tp[0]; cv[1] += bf_hi(cg.x) * bf_hi(vv.x) * tp[1]; cv[2] += bf_lo(cg.y) * bf_lo(vv.y) * tp[2]; cv[3] += bf_hi(cg.y) * bf_hi(vv.y) * tp[3]; }
            o8[64 * q] = (unsigned long long)cvt_pk_bf16(bf_lo(bg.x) * cv[0], bf_hi(bg.x) * cv[1]) | ((unsigned long long)cvt_pk_bf16(bf_lo(bg.y) * cv[2], bf_hi(bg.y) * cv[3]) << 32); }
    }
}
__device__ __forceinline__ void ph_attention(const Ctx& F, unsigned char* lds_generic) {
    unsigned char* ws = KWS(); const bf16* QKV = (const bf16*)(ws + WS_QKV); bf16* OB = (bf16*)(ws + WS_O);
    for (int L = F.vcu; L < 1024 + 64; L += F.G) {
        int pair, hl, qb;
        if (L < 1024) { pair = (L & 255) / 32 + 8 * ((L >> 8) >> 1); const int u = ((L >> 8) & 1) * 32 + (L & 31); hl = u >> 4; qb = 1 + (u & 15); }
        else { const int s = L - 1024; pair = s >> 2; hl = s & 3; qb = 0; }
        const int b = pair >> 1, kvh = pair & 1, h = kvh * 4 + hl;
        const bf16* base = QKV + (size_t)b * RPB * NQKV;
        __syncthreads();
        att::attn_dense_body(base + (size_t)(qb * 256) * NQKV + h * HD, base + NH * HD + kvh * HD, base + (NH + NKV) * HD + kvh * HD,
                             OB + (size_t)(b * RPB + qb * 256) * DM + h * HD, qb == 0 ? CTXL : RPB, (char*)lds_generic, F.tid);
    }
}
__device__ __forceinline__ void ph_ln1(const Ctx& F, int l) {
    unsigned char* ws = KWS(); const float* md_l = (const float*)(ws + WS_MOD) + (size_t)l * 9 * 6144;
    const bf16* YB = (const bf16*)(ws + WS_Y); float* X1 = (float*)(ws + WS_X1); bf16* H2 = (bf16*)(ws + WS_H2); const float* X2 = (const float*)(ws + WS_X2);
    const float* x_in = KIN(0); const float* ctx_in = KIN(2);
    const float* lg = KIN(6) + (size_t)(l * 2 + 0) * DM; const float* lb = KIN(7) + (size_t)(l * 2 + 0) * DM;
    const int TL = l == 0 ? TL0 : TL1;
    for (int tt = F.gw; tt < TL; tt += F.NGW) {
        const int m = tok_row(l, tt), b = m / RPB, j = m % RPB;
        const float* xr = l == 0 ? (j < CTXL ? ctx_in + (size_t)(b * CTXL + j) * DM : x_in + (size_t)(b * SEQ + j - CTXL) * DM) : X2 + (size_t)m * DM;
        const float* md = md_l + (size_t)(j < CTXL ? 8 : b) * 6144;
        const bf16* yr = YB + (size_t)m * DM;
        f32x4 v[4]; float s = 0.f;
#pragma unroll
        for (int q = 0; q < 4; ++q) { const int c = 4 * F.lane + 256 * q; const f32x4 xv = *(const f32x4*)(xr + c), g = *(const f32x4*)(md + 2 * 1024 + c); const u32x2 yw = *(const u32x2*)(yr + c);
            v[q] = xv * DN_ALPHA + g * (f32x4){bf_lo(yw.x), bf_hi(yw.x), bf_lo(yw.y), bf_hi(yw.y)}; s += (v[q][0] + v[q][1]) + (v[q][2] + v[q][3]); }
        const float mean = wave_sum(s) * (1.f / DM); float s2 = 0.f;
#pragma unroll
        for (int q = 0; q < 4; ++q) { v[q] = v[q] - mean; s2 += (v[q][0] * v[q][0] + v[q][1] * v[q][1]) + (v[q][2] * v[q][2] + v[q][3] * v[q][3]); }
        const float rstd = 1.f / sqrtf(wave_sum(s2) * (1.f / DM) + LN_EPS);
        unsigned long long* o8 = (unsigned long long*)(H2 + (size_t)m * DM) + F.lane;
#pragma unroll
        for (int q = 0; q < 4; ++q) { const int c = 4 * F.lane + 256 * q; const f32x4 o = v[q] * rstd * *(const f32x4*)(lg + c) + *(const f32x4*)(lb + c);
            *(f32x4*)(X1 + (size_t)m * DM + c) = o;
            const f32x4 h = o * (*(const f32x4*)(md + 4 * 1024 + c) + 1.0f) + *(const f32x4*)(md + 3 * 1024 + c);
            o8[64 * q] = (unsigned long long)cvt_pk_bf16(h[0], h[1]) | ((unsigned long long)cvt_pk_bf16(h[2], h[3]) << 32); }
    }
}
__device__ __forceinline__ void ph_routing(const Ctx& F, int l) {
    unsigned char* ws = KWS(); const float* LOG = (const float*)(ws + WS_LOG); int* EIDX = (int*)(ws + WS_EIDX); float* GATE = (float*)(ws + WS_GATE);
    unsigned* cnt = (unsigned*)(ws + WS_CTL) + CW_CNT + l * 256;
    const float* rb = KIN(16) + l * NE;
    const f32x4 bs = *(const f32x4*)(rb + 4 * F.lane);
    const int TL = l == 0 ? TL0 : TL1;
    for (int tt = F.gw; tt < TL; tt += F.NGW) {
        const int m = tok_row(l, tt);
        const f32x4 lgv = *(const f32x4*)(LOG + (size_t)m * NE + 4 * F.lane);
        float sc[4], mv[4];
#pragma unroll
        for (int j = 0; j < 4; ++j) { sc[j] = 1.0f / (1.0f + expf(-lgv[j])); mv[j] = sc[j] + bs[j]; }
        float a = fmaxf(fmaxf(mv[0], mv[1]), fmaxf(mv[2], mv[3]));
        float bq; { const float m01 = fmaxf(mv[0], mv[1]), n01 = fminf(mv[0], mv[1]), m23 = fmaxf(mv[2], mv[3]), n23 = fminf(mv[2], mv[3]); bq = fmaxf(fminf(m01, m23), fmaxf(n01, n23)); }
#pragma unroll
        for (int off = 1; off < 8; off <<= 1) { const float a2 = __shfl_xor(a, off), b2 = __shfl_xor(bq, off); const float na = fmaxf(a, a2), nb = fmaxf(fminf(a, a2), fmaxf(bq, b2)); a = na; bq = nb; }
        const float gs = a + bq; const int myg = F.lane >> 3; int rank = 0;
#pragma unroll
        for (int g = 0; g < 8; ++g) { const float og = __shfl(gs, g * 8); rank += (og > gs || (og == gs && g < myg)) ? 1 : 0; }
        if (rank >= 4) { mv[0] = mv[1] = mv[2] = mv[3] = -INFINITY; }
        int my_e = 0; float my_s = 0.f, gsum = 0.f;
#pragma unroll
        for (int k = 0; k < TOPK; ++k) {
            float bv = mv[0]; int bi = 0;
#pragma unroll
            for (int j = 1; j < 4; ++j) if (mv[j] > bv) { bv = mv[j]; bi = j; }
            float cv = bv; int ci = 4 * F.lane + bi;
#pragma unroll
            for (int off = 32; off >= 1; off >>= 1) { const float ov = __shfl_xor(cv, off); const int oi = __shfl_xor(ci, off); if (ov > cv || (ov == cv && oi < ci)) { cv = ov; ci = oi; } }
            const bool mine = (ci >> 2) == F.lane; const int wj = ci & 3;
            const float ssel = wj == 0 ? sc[0] : wj == 1 ? sc[1] : wj == 2 ? sc[2] : sc[3];
            if (mine) {
#pragma unroll
                for (int j = 0; j < 4; ++j) if (wj == j) mv[j] = -INFINITY; }
            const float sw = __shfl(ssel, ci >> 2);
            gsum += sw;
            if (F.lane == k) { my_e = ci; my_s = sw; }
        }
        if (F.lane < TOPK) { EIDX[(size_t)m * 8 + F.lane] = my_e; GATE[(size_t)m * 8 + F.lane] = my_s / gsum * ROUTED_SCALE; atomicAdd(&cnt[my_e], 1u); }
    }
}
__device__ __forceinline__ void build_tables(const Ctx& F, int l) {
    unsigned char* ws = KWS(); unsigned* cnt = (unsigned*)(ws + WS_CTL) + CW_CNT + l * 256;
    LAS int* tstart = (LAS int*)(F.lds + TBL_OFF); LAS int* tmp = (LAS int*)(F.lds + TBL_TMP); LAS unsigned short* texp = (LAS unsigned short*)(F.lds + TBL_EXP);
    const int TL = l == 0 ? TL0 : TL1;
    __syncthreads();
    if (F.tid < NE) tmp[F.tid] = ((int)__hip_atomic_load(&cnt[F.tid], __ATOMIC_RELAXED, __HIP_MEMORY_SCOPE_AGENT) + 255) >> 8;
    __syncthreads();
    if (F.tid <= NE) { int s = 0; for (int e = 0; e < F.tid; ++e) s += tmp[e]; tstart[F.tid] = s; }
    __syncthreads();
    const int nrt = tstart[NE];
    if (F.tid < NE) { for (int t = tstart[F.tid]; t < tstart[F.tid + 1]; ++t) texp[t] = (unsigned short)F.tid; }
    for (int t = nrt + F.tid; t < nrt + TL / 256; t += 512) texp[t] = (unsigned short)NE;
    __syncthreads();
}
__device__ __forceinline__ void ph_scatter(const Ctx& F, int l) {
    unsigned char* ws = KWS(); const int* EIDX = (const int*)(ws + WS_EIDX); int* POS = (int*)(ws + WS_POS); int* TOK = (int*)(ws + WS_TOK);
    unsigned* cnt = (unsigned*)(ws + WS_CTL) + CW_CNT + l * 256; unsigned* fill = (unsigned*)(ws + WS_CTL) + CW_FILL + l * 256;
    const LAS int* tstart = (const LAS int*)(F.lds + TBL_OFF);
    const int TL = l == 0 ? TL0 : TL1; const int nrt = tstart[NE];
    for (int idx = blockIdx.x * 512 + F.tid; idx < TL * 8; idx += F.G * 512) {
        const int tt = idx >> 3, k = idx & 7, m = tok_row(l, tt);
        const int e = EIDX[(size_t)m * 8 + k];
        const int p = tstart[e] * 256 + (int)atomicAdd(&fill[e], 1u);
        TOK[p] = m; POS[(size_t)m * 9 + k] = p;
    }
    for (int tt = blockIdx.x * 512 + F.tid; tt < TL; tt += F.G * 512) { const int m = tok_row(l, tt), p = nrt * 256 + tt; TOK[p] = m; POS[(size_t)m * 9 + 8] = p; }
    for (int e = blockIdx.x; e < NE; e += F.G) {
        const int c = (int)__hip_atomic_load(&cnt[e], __ATOMIC_RELAXED, __HIP_MEMORY_SCOPE_AGENT);
        for (int p = tstart[e] * 256 + c + F.tid; p < tstart[e + 1] * 256; p += 512) TOK[p] = tok_row(l, 0);
    }
}
__device__ __forceinline__ void ph_gemm1(const Ctx& F, int l) {
    unsigned char* ws = KWS(); const LAS int* tstart = (const LAS int*)(F.lds + TBL_OFF);
    const int ntiles = tstart[NE] + (l == 0 ? TL0 : TL1) / 256;
    pg8::ExpertOrder<1> S; S.nunits = ntiles * 2; S.G = F.G; S.c = F.vcu; S.texp = (const LAS unsigned short*)(F.lds + TBL_EXP);
    S.A = (const char*)(ws + WS_H2); S.Bt = (const char*)(ws + WS_WGU) + (size_t)l * 257 * 512 * 1024 * 2; S.toks = (const int*)(ws + WS_TOK); S.a_tstep = 0; S.b_tstep = 256u * 1024u * 2u;
    pg8::EpiSwiGLU E{(bf16*)(ws + WS_ACT)};
    pg8::gemm_phase<pg8::EpiSwiGLU, pg8::ExpertOrder<1>, true>(F.lds, S, E, DM, F.tid);
}
__device__ __forceinline__ void ph_gemm2(const Ctx& F, int l) {
    unsigned char* ws = KWS(); const LAS int* tstart = (const LAS int*)(F.lds + TBL_OFF);
    const int ntiles = tstart[NE] + (l == 0 ? TL0 : TL1) / 256;
    pg8::ExpertOrder<2> S; S.nunits = ntiles * 4; S.G = F.G; S.c = F.vcu; S.texp = (const LAS unsigned short*)(F.lds + TBL_EXP);
    S.A = (const char*)(ws + WS_ACT); S.Bt = (const char*)(ws + WS_WD) + (size_t)l * 257 * 1024 * 256 * 2; S.toks = nullptr; S.a_tstep = 256u * EFF * 2u; S.b_tstep = 256u * EFF * 2u;
    pg8::EpiBf16 E{(bf16*)(ws + WS_YS), DM};
    pg8::gemm_phase<pg8::EpiBf16, pg8::ExpertOrder<2>, false>(F.lds, S, E, EFF, F.tid);
}
__device__ __forceinline__ void ph_ln2(const Ctx& F, int l) {
    unsigned char* ws = KWS(); const float* MOD = (const float*)(ws + WS_MOD); const float* md_l = MOD + (size_t)l * 9 * 6144;
    const float* X1 = (const float*)(ws + WS_X1); const bf16* YS = (const bf16*)(ws + WS_YS); const int* POS = (const int*)(ws + WS_POS); const float* GATE = (const float*)(ws + WS_GATE);
    float* X2 = (float*)(ws + WS_X2); bf16* HX = (bf16*)(ws + WS_HX); float* outp = KOUT();
    const float* lg = KIN(6) + (size_t)(l * 2 + 1) * DM; const float* lb = KIN(7) + (size_t)(l * 2 + 1) * DM;
    const int TL = l == 0 ? TL0 : TL1;
    for (int tt = F.gw; tt < TL; tt += F.NGW) {
        const int m = tok_row(l, tt), b = m / RPB, j = m % RPB;
        const float* md = md_l + (size_t)(j < CTXL ? 8 : b) * 6144;
        f32x4 acc[4];
#pragma unroll
        for (int q = 0; q < 4; ++q) acc[q] = (f32x4){0.f, 0.f, 0.f, 0.f};
#pragma unroll
        for (int k = 0; k < 9; ++k) { const int p = POS[(size_t)m * 9 + k]; const float g = k < 8 ? GATE[(size_t)m * 8 + k] : 1.0f; const bf16* yr = YS + (size_t)p * DM;
#pragma unroll
            for (int q = 0; q < 4; ++q) { const u32x2 yw = *(const u32x2*)(yr + 4 * F.lane + 256 * q); acc[q] += (f32x4){bf_lo(yw.x), bf_hi(yw.x), bf_lo(yw.y), bf_hi(yw.y)} * g; } }
        f32x4 v[4]; float s = 0.f;
#pragma unroll
        for (int q = 0; q < 4; ++q) { const int c = 4 * F.lane + 256 * q; const f32x4 xv = *(const f32x4*)(X1 + (size_t)m * DM + c), g = *(const f32x4*)(md + 5 * 1024 + c);
            v[q] = xv * DN_ALPHA + g * acc[q]; s += (v[q][0] + v[q][1]) + (v[q][2] + v[q][3]); }
        const float mean = wave_sum(s) * (1.f / DM); float s2 = 0.f;
#pragma unroll
        for (int q = 0; q < 4; ++q) { v[q] = v[q] - mean; s2 += (v[q][0] * v[q][0] + v[q][1] * v[q][1]) + (v[q][2] * v[q][2] + v[q][3] * v[q][3]); }
        const float rstd = 1.f / sqrtf(wave_sum(s2) * (1.f / DM) + LN_EPS);
        if (l == 0) {
            const float* md1 = MOD + (size_t)(9 + b) * 6144;
            unsigned long long* o8 = (unsigned long long*)(HX + (size_t)m * DM) + F.lane;
#pragma unroll
            for (int q = 0; q < 4; ++q) { const int c = 4 * F.lane + 256 * q; const f32x4 o = v[q] * rstd * *(const f32x4*)(lg + c) + *(const f32x4*)(lb + c);
                *(f32x4*)(X2 + (size_t)m * DM + c) = o;
                if (j >= CTXL) { const f32x4 h = o * (*(const f32x4*)(md1 + 1024 + c) + 1.0f) + *(const f32x4*)(md1 + c);
                    o8[64 * q] = (unsigned long long)cvt_pk_bf16(h[0], h[1]) | ((unsigned long long)cvt_pk_bf16(h[2], h[3]) << 32); } }
        } else {
            float* orow = outp + (size_t)tt * DM;
#pragma unroll
            for (int q = 0; q < 4; ++q) { const int c = 4 * F.lane + 256 * q; *(f32x4*)(orow + c) = v[q] * rstd * *(const f32x4*)(lg + c) + *(const f32x4*)(lb + c); }
        }
    }
}

#ifndef PH_MASK
#define PH_MASK 0xFFFF
#endif
#define EN(i) (((PH_MASK) >> (i)) & 1)
__global__ void __launch_bounds__(512, 2) fwd(Args args) {
    extern __shared__ __attribute__((aligned(16))) unsigned char lds_raw[];
    Ctx F;
    F.lds = (LAS unsigned char*)lds_raw;
    F.tid = threadIdx.x; F.lane = F.tid & 63; F.wave = __builtin_amdgcn_readfirstlane(F.tid >> 6);
    F.G = gridDim.x; { const int bx = blockIdx.x; F.vcu = (F.G % 8 == 0) ? (bx % 8) * (F.G / 8) + bx / 8 : bx; }
    F.gw = blockIdx.x * 8 + F.wave; F.NGW = F.G * 8;
    volatile LAS unsigned* MISC = (volatile LAS unsigned*)(F.lds + MISC_OFF);
    if (F.tid < 64) MISC[F.tid] = 0u;
    __syncthreads();
    const int lo = args.ph_lo, hi = args.ph_hi;
    XcdBarrier bar; bar.bar = (unsigned*)(args.ws + WS_CTL) + CW_BAR; bar.x = 0; bar.st = MISC + 8;
    if (hi - lo > 1) bar = xcd_barrier_post((unsigned*)(args.ws + WS_CTL) + CW_BAR, MISC + 8);
#define IN(k) (lo <= (k) && (k) < hi)
#define SEAM(k) do { if (IN(k) && IN((k) + 1)) xcd_barrier(bar); } while (0)
#define FRESH() asm volatile("" : "+v"(F.tid), "+v"(F.lane))

    if (EN(0) && IN(0)) { FRESH(); ph_prologue(F); }
    SEAM(0);
    if (EN(1) && IN(1)) { FRESH(); ph_modulate0(F); }
    SEAM(1);
    for (int l = 0; l < 2; ++l) {
        const int P0 = 2 + 11 * l;
        if (EN(2) && IN(P0 + 0)) { FRESH(); ph_gemm_in(F, l); }
        SEAM(P0 + 0);
        if (EN(3) && IN(P0 + 1)) { FRESH(); if (l == 0) ph_normrope(F); else ph_conv(F); }
        SEAM(P0 + 1);
        if (l == 0) {
            if (EN(4) && IN(P0 + 2)) { FRESH(); ph_attention(F, lds_raw); }
            SEAM(P0 + 2);
        }
        if (EN(5) && IN(P0 + 3)) { FRESH(); ph_gemm_out(F, l); }
        SEAM(P0 + 3);
        if (EN(6) && IN(P0 + 4)) { FRESH(); ph_ln1(F, l); }
        SEAM(P0 + 4);
        if (EN(7) && IN(P0 + 5)) { FRESH(); ph_router(F, l); }
        SEAM(P0 + 5);
        if (EN(8) && IN(P0 + 6)) { FRESH(); ph_routing(F, l); }
        SEAM(P0 + 6);
        if ((EN(9) && IN(P0 + 7)) || (EN(10) && IN(P0 + 8)) || (EN(11) && IN(P0 + 9))) { FRESH(); build_tables(F, l); }
        if (EN(9) && IN(P0 + 7)) { FRESH(); ph_scatter(F, l); }
        SEAM(P0 + 7);
        if (EN(10) && IN(P0 + 8)) { FRESH(); ph_gemm1(F, l); }
        SEAM(P0 + 8);
        if (EN(11) && IN(P0 + 9)) { FRESH(); ph_gemm2(F, l); }
        SEAM(P0 + 9);
        if (EN(12) && IN(P0 + 10)) { FRESH(); ph_ln2(F, l); }
        if (l == 0) SEAM(P0 + 10);
    }
#undef IN
#undef SEAM
}

constexpr int N_PHASES = 2 + 22;
extern "C" void kernel_launch(void* const* d_in, const int* in_sizes, int n_in, void* d_out, int out_size, void* d_ws, size_t ws_size, hipStream_t stream) {
    static int grid = 0;
    if (grid == 0) {
        if (n_in != 21 || out_size != NB * SEQ * DM || ws_size < WS_END) { fprintf(stderr, "kernel_launch: unexpected shapes (n_in %d out %d ws %zu)\n", n_in, out_size, ws_size); grid = -1; return; }
        int dev = 0, cus = 0, per_cu = 0;
        if (hipGetDevice(&dev) != hipSuccess || hipDeviceGetAttribute(&cus, hipDeviceAttributeMultiprocessorCount, dev) != hipSuccess) { grid = -1; return; }
        if (hipFuncSetAttribute((const void*)fwd, hipFuncAttributeMaxDynamicSharedMemorySize, LDS_BYTES) != hipSuccess) { fprintf(stderr, "kernel_launch: hipFuncSetAttribute failed\n"); grid = -1; return; }
        if (hipOccupancyMaxActiveBlocksPerMultiprocessor(&per_cu, (const void*)fwd, 512, LDS_BYTES) != hipSuccess || per_cu < 1) { fprintf(stderr, "kernel_launch: occupancy query says %d\n", per_cu); (void)hipGetLastError(); grid = -1; return; }
        grid = cus;
    }
    if (grid < 0) return;
    (void)hipMemsetAsync((char*)d_ws + WS_CTL, 0, CTL_ZERO_BYTES, stream);
    Args a{};
    for (int i = 0; i < 21; ++i) a.in[i] = (const float*)d_in[i];
    a.out = (float*)d_out; a.ws = (unsigned char*)d_ws;
#if MK_ONE_LAUNCH
    a.ph_lo = 0; a.ph_hi = N_PHASES;
    hipLaunchKernelGGL(fwd, dim3(grid), dim3(512), LDS_BYTES, stream, a);
#else
    for (int p = 0; p < N_PHASES; ++p) {
        if (p == 2 + 11 + 2) continue;
        a.ph_lo = p; a.ph_hi = p + 1;
        hipLaunchKernelGGL(fwd, dim3(grid), dim3(512), LDS_BYTES, stream, a);
    }
#endif
    const hipError_t le = hipPeekAtLastError();
    if (le != hipSuccess) fprintf(stderr, "kernel_launch: launch failed: %s\n", hipGetErrorName(le));
}
```

```cpp
#include <hip/hip_runtime.h>
#include <cstdio>
#include <cstdint>

#ifndef MK_ONE_LAUNCH
#define MK_ONE_LAUNCH 1
#endif
#ifndef USE_SIMPLE_GEMM
#define USE_SIMPLE_GEMM 0
#endif

#define GAS __attribute__((address_space(1)))
#define LAS __attribute__((address_space(3)))
typedef unsigned short bf16;
typedef short bf16x8 __attribute__((ext_vector_type(8)));
typedef short s16x4 __attribute__((ext_vector_type(4)));
typedef float f32x4 __attribute__((ext_vector_type(4)));
typedef float f32x16 __attribute__((ext_vector_type(16)));
typedef unsigned u32x4 __attribute__((ext_vector_type(4)));
typedef unsigned u32x2 __attribute__((ext_vector_type(2)));

constexpr int NB = 8, SEQ = 4096, CTXL = 256, DM = 1024, RPB = SEQ + CTXL  , MROWS = NB * RPB  ;
constexpr int NH = 8, NKV = 2, HD = 128, NQKV = (NH + 2 * NKV) * HD  , NWIN = 3 * DM;
constexpr int NE = 256, TOPK = 8, EFF = 256;
constexpr int TL0 = MROWS, TL1 = NB * SEQ;
constexpr float LN_EPS = 1e-5f, QK_EPS = 1e-6f, DN_ALPHA = 1.4142135623730951f, ROUTED_SCALE = 2.5f;
constexpr int P_MAX = MROWS * 9 + 65536;

constexpr size_t MiB = 1u << 20;
constexpr size_t WS_CTL = 0, CTL_ZERO_BYTES = 1 * MiB;
constexpr size_t WS_MOD = 1 * MiB;
constexpr size_t WS_ROPE = 2 * MiB;
constexpr size_t WS_WQKV = 4 * MiB;
constexpr size_t WS_WO = 7 * MiB;
constexpr size_t WS_WIN = 9 * MiB;
constexpr size_t WS_WOUT = 15 * MiB;
constexpr size_t WS_WR = 17 * MiB;
constexpr size_t WS_WGU = 18 * MiB;
constexpr size_t WS_WD = 532 * MiB;
constexpr size_t WS_HX = 789 * MiB;
constexpr size_t WS_QKV = 857 * MiB;
constexpr size_t WS_O = 1061 * MiB;
constexpr size_t WS_Y = 1129 * MiB;
constexpr size_t WS_X1 = 1197 * MiB;
constexpr size_t WS_H2 = 1333 * MiB;
constexpr size_t WS_LOG = 1401 * MiB;
constexpr size_t WS_EIDX = 1435 * MiB;
constexpr size_t WS_GATE = 1437 * MiB;
constexpr size_t WS_POS = 1439 * MiB;
constexpr size_t WS_TOK = 1441 * MiB;
constexpr size_t WS_ACT = 1443 * MiB;
constexpr size_t WS_YS = 1628 * MiB;
constexpr size_t WS_X2 = 2368 * MiB;
constexpr size_t WS_END = 2504 * MiB;
static_assert(WS_ACT + (size_t)P_MAX * 256 * 2 <= WS_YS && WS_YS + (size_t)P_MAX * 1024 * 2 <= WS_X2 && WS_X2 + (size_t)MROWS * 1024 * 4 <= WS_END, "ws map");
static_assert(WS_WGU + (size_t)2 * 257 * 512 * 1024 * 2 <= WS_WD && WS_WD + (size_t)2 * 257 * 1024 * 256 * 2 <= WS_HX, "ws map w");
static_assert(WS_QKV + (size_t)MROWS * 3072 * 2 <= WS_O && WS_X1 + (size_t)MROWS * 1024 * 4 <= WS_H2 && WS_LOG + (size_t)MROWS * 256 * 4 <= WS_EIDX, "ws map a");
constexpr int CW_BAR = 4096;
constexpr int CW_CNT = 16384;
constexpr int CW_FILL = 16384 + 1024;

constexpr int RING_BYTES = 131072;
constexpr int MISC_OFF = RING_BYTES;
constexpr int TBL_OFF = RING_BYTES + 512;
constexpr int TBL_TMP = TBL_OFF + 1088, TBL_EXP = TBL_TMP + 1024;
constexpr int LDS_BYTES = 147456;

__device__ __forceinline__ unsigned cvt_pk_bf16(float lo, float hi) { unsigned r; asm volatile("v_cvt_pk_bf16_f32 %0, %1, %2" : "=v"(r) : "v"(lo), "v"(hi)); return r; }
__device__ __forceinline__ float bf_lo(unsigned w) { return __uint_as_float(w << 16); }
__device__ __forceinline__ float bf_hi(unsigned w) { return __uint_as_float(w & 0xffff0000u); }
__device__ __forceinline__ float wave_sum(float v) {
#pragma unroll
    for (int o = 1; o < 64; o <<= 1) v += __shfl_xor(v, o);
    return v;
}
__device__ __forceinline__ float silu_f(float g) { return g * __builtin_amdgcn_rcpf(1.0f + __builtin_amdgcn_exp2f(-1.4426950408889634f * g)); }

#define XB_TMO      128
#define XB_XCNT(j)  (256  + 64 * (j))
#define XB_XSUB(j)  (1280 + 64 * (j))
#define XB_XGEN(j)  (2304 + 64 * (j))
#define XB_TOP      3328
#define XB_TOPGEN   3392
#define XCD_BAR_WORDS 3456
#define XB_SPIN_CAP (1u << 18)

__device__ __forceinline__ unsigned xb_ld(unsigned* p)              { return __hip_atomic_load(p, __ATOMIC_RELAXED, __HIP_MEMORY_SCOPE_AGENT); }
__device__ __forceinline__ unsigned xb_add(unsigned* p, unsigned v) { return __hip_atomic_fetch_add(p, v, __ATOMIC_RELAXED, __HIP_MEMORY_SCOPE_AGENT); }
__device__ __forceinline__ unsigned xb_xcc_id() { return (unsigned)__builtin_amdgcn_s_getreg((3 << 11) | 20) & 0xFu; }
#define XB_SPIN(cond, bar) do { unsigned _sp = 0; while (cond) { __builtin_amdgcn_s_sleep(1); \
    if ((++_sp & 255u) == 0u) { if (xb_ld(&(bar)[XB_TMO])) break; if (_sp > XB_SPIN_CAP) { atomicAdd(&(bar)[XB_TMO], 1u); break; } } } } while (0)

struct XcdBarrier { unsigned* bar; unsigned x; volatile LAS unsigned* st; };

__device__ __forceinline__ XcdBarrier xcd_barrier_post(unsigned* bar, volatile LAS unsigned* st) {
    XcdBarrier b; b.bar = bar; b.x = xb_xcc_id(); b.st = st;
    if (threadIdx.x == 0) (void)xb_add(&bar[XB_XCNT(b.x)], 1u);
    return b;
}
__device__ __forceinline__ void xcd_barrier_complete(unsigned* bar, unsigned x, unsigned& nloc, unsigned& nx) {
    const unsigned G = gridDim.x * gridDim.y * gridDim.z;
    unsigned sum, cnt, mine, sp = 0u;
    for (;;) {
        sum = 0u; cnt = 0u; mine = 0u;
#pragma unroll
        for (unsigned j = 0; j < 16; ++j) { const unsigned c = xb_ld(&bar[XB_XCNT(j)]); sum += c; cnt += (c > 0u) ? 1u : 0u; mine = (j == x) ? c : mine; }
        if (sum == G) break;
        __builtin_amdgcn_s_sleep(1);
        if ((++sp & 255u) == 0u) { if (xb_ld(&bar[XB_TMO])) break; if (sp > XB_SPIN_CAP) { atomicAdd(&bar[XB_TMO], 1u); break; } }
    }
    nloc = mine > 0u ? mine : 1u; nx = cnt > 0u ? cnt : 1u;
}
__device__ __forceinline__ void xcd_barrier(const XcdBarrier& b) {
    asm volatile("s_waitcnt vmcnt(0)" ::: "memory");
    __syncthreads();
    if (threadIdx.x == 0) {
        unsigned* bar = b.bar;
        __builtin_amdgcn_s_waitcnt(0);
        unsigned nloc = b.st[0], nx = b.st[1];
        if (nloc == 0u) { xcd_barrier_complete(bar, b.x, nloc, nx); b.st[0] = nloc; b.st[1] = nx; }
        const unsigned old = xb_add(&bar[XB_XSUB(b.x)], 1u);
        const unsigned gen = old / nloc;
        if (old + 1u == (gen + 1u) * nloc) {
            __builtin_amdgcn_fence(__ATOMIC_RELEASE, "agent");
            asm volatile("s_waitcnt vmcnt(0)" ::: "memory");
            const unsigned og = xb_add(&bar[XB_TOP], 1u);
            const unsigned tg = og / nx;
            if (og + 1u == (tg + 1u) * nx) xb_add(&bar[XB_TOPGEN], 1u);
            else XB_SPIN(xb_ld(&bar[XB_TOPGEN]) == tg, bar);
            __builtin_amdgcn_fence(__ATOMIC_ACQUIRE, "agent");
            xb_add(&bar[XB_XGEN(b.x)], 1u);
            asm volatile("s_waitcnt vmcnt(0)" ::: "memory");
        } else {
            XB_SPIN(xb_ld(&bar[XB_XGEN(b.x)]) == gen, bar);
            __builtin_amdgcn_fence(__ATOMIC_ACQUIRE, "agent");
            asm volatile("s_waitcnt vmcnt(0)" ::: "memory");
        }
    }
    __syncthreads();
}

namespace pg8 {
constexpr int BM = 256, BK = 64, HALF = 128, HTB = HALF * BK * 2, STAGE_BYTES = 8 * HTB;
__host__ __device__ __forceinline__ int lds_byte(int r, int c) { const int st = (r >> 4) * 2 + (c >> 5), rr = r & 15, cc = c & 31, ob = rr * 64 + cc * 2; return st * 1024 + (ob ^ (((ob >> 9) & 1) << 5)); }
__host__ __device__ __forceinline__ void stage_rc(int b, int& R, int& C) { const int st = b / 1024, sb = b % 1024, swz = sb ^ (((sb >> 9) & 1) << 5); R = (st >> 1) * 16 + swz / 64; C = (st & 1) * 32 + (swz % 64) / 2; }
__host__ __device__ __forceinline__ int perm32(int rho) { const int n = rho >> 4, i = rho & 15; return 8 * (i >> 2) + 4 * n + (i & 3); }

struct Unit { int rt, pn, ex; };

struct EpiBf16 {
    bf16* O; int ldc;
    __device__ __forceinline__ void operator()(const f32x4 (&acc)[2][2][4][2], const Unit& u, int wr, int wc, int fr, int fq) const {
        const int row0 = u.rt * BM + wr * 64 + fr, col0 = u.pn * BM + wc * 32 + 8 * fq;
#pragma unroll
        for (int ai = 0; ai < 2; ++ai)
#pragma unroll
            for (int m = 0; m < 4; ++m) { bf16* rowp = O + (size_t)(row0 + ai * HALF + m * 16) * ldc + col0;
#pragma unroll
                for (int bj = 0; bj < 2; ++bj) { const f32x4 v0 = acc[ai][bj][m][0], v1 = acc[ai][bj][m][1];
                    u32x4 w; w.x = cvt_pk_bf16(v0[0], v0[1]); w.y = cvt_pk_bf16(v0[2], v0[3]); w.z = cvt_pk_bf16(v1[0], v1[1]); w.w = cvt_pk_bf16(v1[2], v1[3]);
                    *(u32x4*)(rowp + bj * HALF) = w; } }
    }
};
struct EpiF32 {
    float* C; int ldc;
    __device__ __forceinline__ void operator()(const f32x4 (&acc)[2][2][4][2], const Unit& u, int wr, int wc, int fr, int fq) const {
        const int row0 = u.rt * BM + wr * 64 + fr, col0 = u.pn * BM + wc * 32 + 8 * fq;
#pragma unroll
        for (int ai = 0; ai < 2; ++ai)
#pragma unroll
            for (int m = 0; m < 4; ++m) { float* rowp = C + (size_t)(row0 + ai * HALF + m * 16) * ldc + col0;
#pragma unroll
                for (int bj = 0; bj < 2; ++bj) { *(f32x4*)(rowp + bj * HALF) = acc[ai][bj][m][0]; *(f32x4*)(rowp + bj * HALF + 4) = acc[ai][bj][m][1]; } }
    }
};
struct EpiSwiGLU {
    bf16* O;
    __device__ __forceinline__ void operator()(const f32x4 (&acc)[2][2][4][2], const Unit& u, int wr, int wc, int fr, int fq) const {
        const int row0 = u.rt * BM + wr * 64 + fr, col0 = u.pn * HALF + wc * 32 + 8 * fq;
#pragma unroll
        for (int ai = 0; ai < 2; ++ai)
#pragma unroll
            for (int m = 0; m < 4; ++m) { bf16* rowp = O + (size_t)(row0 + ai * HALF + m * 16) * EFF + col0;
                float r[8];
#pragma unroll
                for (int n = 0; n < 2; ++n)
#pragma unroll
                    for (int j = 0; j < 4; ++j) r[n * 4 + j] = silu_f(acc[ai][0][m][n][j]) * acc[ai][1][m][n][j];
                u32x4 w; w.x = cvt_pk_bf16(r[0], r[1]); w.y = cvt_pk_bf16(r[2], r[3]); w.z = cvt_pk_bf16(r[4], r[5]); w.w = cvt_pk_bf16(r[6], r[7]);
                *(u32x4*)rowp = w; }
    }
};

struct DenseOrder {
    int nM, nN, nwg, G, c, latent; const char* A; const char* Bt; size_t tstep;
    __device__ void init(int nM_, int nN_, int G_, int c_, int latent_, const void* A_, const void* Bt_, int K) { nM = nM_; nN = nN_; nwg = nM * nN; G = G_; c = c_; latent = latent_; A = (const char*)A_; Bt = (const char*)Bt_; tstep = (size_t)BM * K * 2; }
    __device__ __forceinline__ bool next(int i, Unit& u) const {
        const long L = (long)i * G + c; if (L >= nwg) return false;
        int wgid = (int)L; { const int q = nwg / 8, r = nwg % 8, xcd = wgid % 8, off = wgid / 8; wgid = (xcd < r ? xcd * (q + 1) : r * (q + 1) + (xcd - r) * q) + off; }
        const int nig = 8 * nN, gid = wgid / nig, fm = gid * 8, gsz = (nM - fm) < 8 ? (nM - fm) : 8;
        const int pm = fm + ((wgid % nig) % gsz); u.pn = (wgid % nig) / gsz; u.ex = 0;
        u.rt = latent ? (pm >> 4) * 17 + 1 + (pm & 15) : pm; return true;
    }
    __device__ __forceinline__ const char* a_base(const Unit& u) const { return A + (size_t)u.rt * tstep; }
    __device__ __forceinline__ const char* b_base(const Unit& u) const { return Bt + (size_t)u.pn * tstep; }
    __device__ __forceinline__ const int* tok(const Unit&) const { return nullptr; }
};
template <int NTN_LOG2>
struct ExpertOrder {
    int nunits, G, c; const LAS unsigned short* texp; const char* A; const char* Bt; const int* toks; unsigned a_tstep, b_tstep;
    __device__ __forceinline__ bool next(int i, Unit& u) const {
        const int L = i * G + c; if (L >= nunits) return false;
        const int tile = L >> NTN_LOG2; u.pn = L & ((1 << NTN_LOG2) - 1); u.rt = tile; u.ex = (int)texp[tile]; return true;
    }
    __device__ __forceinline__ const char* a_base(const Unit& u) const { return A + (size_t)u.rt * a_tstep; }
    __device__ __forceinline__ const char* b_base(const Unit& u) const { return Bt + (size_t)((u.ex << NTN_LOG2) + u.pn) * b_tstep; }
    __device__ __forceinline__ const int* tok(const Unit& u) const { return toks + (size_t)u.rt * BM; }
};

#if !USE_SIMPLE_GEMM
template <class Epi, class Sched, bool GATHER>
__device__ __forceinline__ void gemm_phase(LAS unsigned char* lds, const Sched& S, const Epi& E, const int K, const int tid) {
    const int wid = __builtin_amdgcn_readfirstlane(tid >> 6), lane = tid & 63, wr = wid >> 2, wc = wid & 3, fr = lane & 15, fq = lane >> 4;
    const int nt = K / BK;
    int Rr[2], Cc[2];
    unsigned voffB[2];
#pragma unroll
    for (int i = 0; i < 2; ++i) { int R, C; stage_rc(tid * 16 + i * 8192, R, C); const int Rb = (R & ~31) + perm32(R & 31); Rr[i] = R; Cc[i] = C; voffB[i] = (unsigned)(Rb * K + C) * 2u; }
    const size_t kstep = (size_t)(BK * 2);
    const size_t hstep = (size_t)HALF * K * 2;
    const unsigned ldsw = (unsigned)wid * 1024u;
    const int aoff = lds_byte(wr * 64 + fr, fq * 8), boff = lds_byte(wc * 32 + fr, fq * 8);
#define PG8_SA(b, h) (((b) * 2 + (h)) * HTB)
#define PG8_SB(b, h) ((4 + (b) * 2 + (h)) * HTB)
#define PG8_STAGE2(bufoff, gbase, v0, v1) do { \
        __builtin_amdgcn_global_load_lds((const unsigned*)((const char*)(gbase) + (v0)), (LAS unsigned*)(lds + (bufoff) + ldsw), 16, 0, 0); \
        __builtin_amdgcn_global_load_lds((const unsigned*)((const char*)(gbase) + (v1)), (LAS unsigned*)(lds + (bufoff) + ldsw + 8192), 16, 0, 0); } while (0)
#define PG8_STAGEB(bufoff, gbase) PG8_STAGE2(bufoff, gbase, voffB[0], voffB[1])
#define PG8_LDA(dst, b, h) do { _Pragma("unroll") for (int m = 0; m < 4; ++m) _Pragma("unroll") for (int k = 0; k < 2; ++k) dst[m][k] = *(const LAS bf16x8*)(lds + PG8_SA(b, h) + aoff + m * 2048 + k * 1024); } while (0)
#define PG8_LDB(dst, b, h) do { _Pragma("unroll") for (int n = 0; n < 2; ++n) _Pragma("unroll") for (int k = 0; k < 2; ++k) dst[n][k] = *(const LAS bf16x8*)(lds + PG8_SB(b, h) + boff + n * 2048 + k * 1024); } while (0)
#define PG8_MMA(ai, bj, At, Bt) do { __builtin_amdgcn_s_setprio(1); _Pragma("unroll") for (int m = 0; m < 4; ++m) _Pragma("unroll") for (int n = 0; n < 2; ++n) _Pragma("unroll") for (int k = 0; k < 2; ++k) \
        acc[ai][bj][m][n] = __builtin_amdgcn_mfma_f32_16x16x32_bf16(Bt[n][k], At[m][k], acc[ai][bj][m][n], 0, 0, 0); __builtin_amdgcn_s_setprio(0); } while (0)
#define PG8_WAIT_V(n) asm volatile("s_waitcnt vmcnt(" #n ")" ::: "memory")
#define PG8_WAIT_L(n) asm volatile("s_waitcnt lgkmcnt(" #n ")" ::: "memory")
#define PG8_BAR __builtin_amdgcn_s_barrier()
#define PG8_SCHED __builtin_amdgcn_sched_barrier(0)
    Unit cur, nxt; int ui = 0;
    if (!S.next(0, cur)) return;
    f32x4 acc[2][2][4][2];
#pragma unroll
    for (int a = 0; a < 2; ++a)
#pragma unroll
        for (int b = 0; b < 2; ++b)
#pragma unroll
            for (int m = 0; m < 4; ++m)
#pragma unroll
                for (int n = 0; n < 2; ++n) acc[a][b][m][n] = (f32x4){0.f, 0.f, 0.f, 0.f};
    bf16x8 At[4][2], B0[2][2], B1[2][2];
    unsigned c00, c01, c10, c11, n00, n01, n10, n11;
    if constexpr (GATHER) { const int* tk = S.tok(cur);
        c00 = (unsigned)(tk[Rr[0]] * K + Cc[0]) * 2u; c01 = (unsigned)(tk[Rr[1]] * K + Cc[1]) * 2u; c10 = (unsigned)(tk[HALF + Rr[0]] * K + Cc[0]) * 2u; c11 = (unsigned)(tk[HALF + Rr[1]] * K + Cc[1]) * 2u;
    } else { c00 = (unsigned)(Rr[0] * K + Cc[0]) * 2u; c01 = (unsigned)(Rr[1] * K + Cc[1]) * 2u; c10 = c00 + (unsigned)hstep; c11 = c01 + (unsigned)hstep; }
    n00 = c00; n01 = c01; n10 = c10; n11 = c11;
    const char* cA = S.a_base(cur); const char* cB = S.b_base(cur);
    PG8_STAGEB(PG8_SB(0, 0), cB); PG8_STAGEB(PG8_SB(0, 1), cB + hstep); PG8_STAGE2(PG8_SA(0, 0), cA, c00, c01); PG8_STAGE2(PG8_SA(0, 1), cA, c10, c11);
    if (wr == 1) PG8_BAR;
    PG8_WAIT_V(2); PG8_BAR;
    PG8_STAGEB(PG8_SB(1, 0), cB + kstep); PG8_STAGE2(PG8_SA(1, 0), cA + kstep, c00, c01); PG8_STAGEB(PG8_SB(1, 1), cB + hstep + kstep);
    PG8_WAIT_V(6); PG8_BAR;
    for (;;) {
        const bool has_next = S.next(ui + 1, nxt);
        const char* nA = has_next ? S.a_base(nxt) : cA; const char* nB = has_next ? S.b_base(nxt) : cB;
        if constexpr (GATHER) { if (has_next) { const int* tk = S.tok(nxt);
            n00 = (unsigned)(tk[Rr[0]] * K + Cc[0]) * 2u; n01 = (unsigned)(tk[Rr[1]] * K + Cc[1]) * 2u; n10 = (unsigned)(tk[HALF + Rr[0]] * K + Cc[0]) * 2u; n11 = (unsigned)(tk[HALF + Rr[1]] * K + Cc[1]) * 2u; }
            else { n00 = c00; n01 = c01; n10 = c10; n11 = c11; } }
#pragma nounroll
        for (int t = 0; t < nt; t += 2) {
            const bool last = (t == nt - 2);
            const char* a1 = cA + (size_t)(t + 1) * kstep;
            const char* a2 = last ? nA : cA + (size_t)(t + 2) * kstep; const char* b2 = last ? nB : cB + (size_t)(t + 2) * kstep;
            const char* a3 = a2 + kstep; const char* b3 = b2 + kstep;
            const unsigned s00 = last ? n00 : c00, s01 = last ? n01 : c01, s10 = last ? n10 : c10, s11 = last ? n11 : c11;
            PG8_LDB(B0, 0, 0); PG8_LDB(B1, 0, 1); PG8_SCHED; PG8_LDA(At, 0, 0); PG8_STAGE2(PG8_SA(1, 1), a1, c10, c11);
            PG8_WAIT_V(8); PG8_WAIT_L(0); PG8_BAR; PG8_MMA(0, 0, At, B0); PG8_MMA(0, 1, At, B1); PG8_BAR; PG8_SCHED;
            PG8_LDA(At, 0, 1); PG8_STAGEB(PG8_SB(0, 0), b2); PG8_STAGEB(PG8_SB(0, 1), b2 + hstep); PG8_STAGE2(PG8_SA(0, 0), a2, s00, s01);
            PG8_WAIT_V(8); PG8_WAIT_L(0); PG8_BAR; PG8_MMA(1, 0, At, B0); PG8_MMA(1, 1, At, B1); PG8_BAR; PG8_SCHED;
            PG8_LDB(B0, 1, 0); PG8_LDB(B1, 1, 1); PG8_SCHED; PG8_LDA(At, 1, 0); PG8_STAGE2(PG8_SA(0, 1), a2, s10, s11);
            PG8_WAIT_V(8); PG8_WAIT_L(0); PG8_BAR; PG8_MMA(0, 0, At, B0); PG8_MMA(0, 1, At, B1); PG8_BAR; PG8_SCHED;
            PG8_LDA(At, 1, 1); PG8_STAGEB(PG8_SB(1, 0), b3); PG8_STAGEB(PG8_SB(1, 1), b3 + hstep); PG8_STAGE2(PG8_SA(1, 0), a3, s00, s01);
            PG8_WAIT_V(8); PG8_WAIT_L(0); PG8_BAR; PG8_MMA(1, 0, At, B0); PG8_MMA(1, 1, At, B1); PG8_BAR; PG8_SCHED;
        }
        if (wr == 0) PG8_BAR;
        E(acc, cur, wr, wc, fr, fq);
        if (!has_next) break;
#pragma unroll
        for (int a = 0; a < 2; ++a)
#pragma unroll
            for (int b = 0; b < 2; ++b)
#pragma unroll
                for (int m = 0; m < 4; ++m)
#pragma unroll
                    for (int n = 0; n < 2; ++n) acc[a][b][m][n] = (f32x4){0.f, 0.f, 0.f, 0.f};
        cur = nxt; cA = nA; cB = nB; ++ui; c00 = n00; c01 = n01; c10 = n10; c11 = n11;
        if (wr == 1) PG8_BAR;
    }
    PG8_WAIT_V(0);
    PG8_BAR;
#undef PG8_SA
#undef PG8_SB
#undef PG8_STAGE2
#undef PG8_STAGEB
#undef PG8_LDA
#undef PG8_LDB
#undef PG8_MMA
#undef PG8_WAIT_V
#undef PG8_WAIT_L
#undef PG8_BAR
#undef PG8_SCHED
}
#else
template <class Epi, class Sched, bool GATHER>
__device__ __forceinline__ void gemm_phase(LAS unsigned char*, const Sched& S, const Epi& E, const int K, const int tid) {
    const int wid = __builtin_amdgcn_readfirstlane(tid >> 6), lane = tid & 63, wr = wid >> 2, wc = wid & 3, fr = lane & 15, fq = lane >> 4;
    for (int ui = 0;; ++ui) {
        Unit u; if (!S.next(ui, u)) break;
        f32x4 acc[2][2][4][2];
#pragma unroll
        for (int a = 0; a < 2; ++a)
#pragma unroll
            for (int b = 0; b < 2; ++b)
#pragma unroll
                for (int m = 0; m < 4; ++m)
#pragma unroll
                    for (int n = 0; n < 2; ++n) acc[a][b][m][n] = (f32x4){0.f, 0.f, 0.f, 0.f};
        const char* Ab = S.a_base(u); const char* Bb = S.b_base(u);
        unsigned ao[2][4], bo[2][2];
#pragma unroll
        for (int ai = 0; ai < 2; ++ai)
#pragma unroll
            for (int m = 0; m < 4; ++m) { const int r = ai * HALF + wr * 64 + m * 16 + fr; int rr = r; if constexpr (GATHER) rr = S.tok(u)[r]; ao[ai][m] = (unsigned)(rr * K + fq * 8) * 2u; }
#pragma unroll
        for (int bj = 0; bj < 2; ++bj)
#pragma unroll
            for (int n = 0; n < 2; ++n) { const int r = bj * HALF + wc * 32 + 8 * (fr >> 2) + 4 * n + (fr & 3); bo[bj][n] = (unsigned)(r * K + fq * 8) * 2u; }
        for (int k0 = 0; k0 < K; k0 += 32) {
            bf16x8 Af[2][4], Bf[2][2];
#pragma unroll
            for (int ai = 0; ai < 2; ++ai)
#pragma unroll
                for (int m = 0; m < 4; ++m) Af[ai][m] = *(const bf16x8*)(Ab + ao[ai][m] + k0 * 2);
#pragma unroll
            for (int bj = 0; bj < 2; ++bj)
#pragma unroll
                for (int n = 0; n < 2; ++n) Bf[bj][n] = *(const bf16x8*)(Bb + bo[bj][n] + k0 * 2);
#pragma unroll
            for (int ai = 0; ai < 2; ++ai)
#pragma unroll
                for (int bj = 0; bj < 2; ++bj)
#pragma unroll
                    for (int m = 0; m < 4; ++m)
#pragma unroll
                        for (int n = 0; n < 2; ++n) acc[ai][bj][m][n] = __builtin_amdgcn_mfma_f32_16x16x32_bf16(Bf[bj][n], Af[ai][m], acc[ai][bj][m][n], 0, 0, 0);
        }
        E(acc, u, wr, wc, fr, fq);
    }
}
#endif
}

namespace att {
constexpr int D = 128, NW = 8, QBLK = 32, KVBLK = 64;
constexpr float SCALE = 0.088388347648318440f, THR = 8.f;
#ifndef ATT_SDEPTH
#define ATT_SDEPTH 1
#endif
constexpr int SDEPTH = ATT_SDEPTH;
constexpr int LDQ = NQKV, LDK = NQKV, LDO = DM;
constexpr size_t SHM_V = KVBLK * D * 2, SHM_K = KVBLK * D * 2, SHM_ATTN = 2 * SHM_V + 2 * SHM_K + NW * 64 * 4;
#define KSWZ(row, colB) ((row) * 256 + ((colB) ^ (((row) & 7) << 4)))
#define SBAR() __builtin_amdgcn_sched_barrier(0)
__device__ __forceinline__ int crow(int r, int hi) { return (r & 3) + 8 * (r >> 2) + 4 * hi; }
__device__ __forceinline__ unsigned cvtpk(float lo, float hi) { unsigned r; asm volatile("v_cvt_pk_bf16_f32 %0, %1, %2" : "=v"(r) : "v"(lo), "v"(hi)); return r; }
__device__ __forceinline__ bf16x8 ld8(const bf16* p) { return *reinterpret_cast<const bf16x8*>(p); }

__device__ __forceinline__ void partialSM(f32x16& p0, f32x16& p1, float& m_reg, float& mn, float& alpha) {
  constexpr float C = SCALE * 1.4426950408889634f;
  float pmax = p0[0]; for (int r = 1; r < 16; ++r) pmax = fmaxf(pmax, p0[r]); for (int r = 0; r < 16; ++r) pmax = fmaxf(pmax, p1[r]);
  { auto rr = __builtin_amdgcn_permlane32_swap(__float_as_uint(pmax), __float_as_uint(pmax), false, false);
    pmax = fmaxf(__uint_as_float(rr[0]), __uint_as_float(rr[1])); }
  if (__builtin_expect(__all(pmax - m_reg <= THR / SCALE), 1)) { mn = m_reg; alpha = 1.f; }
  else { mn = fmaxf(m_reg, pmax); alpha = __builtin_amdgcn_exp2f((m_reg - mn) * C); m_reg = mn; }
  float mnC = -mn * C;
  for (int r = 0; r < 16; ++r) p0[r] = fmaf(p0[r], C, mnC); for (int r = 0; r < 16; ++r) p1[r] = fmaf(p1[r], C, mnC);
  for (int r = 0; r < 16; ++r) p0[r] = __builtin_amdgcn_exp2f(p0[r]);
}
__device__ __forceinline__ void finishSM(f32x16& p0, f32x16& p1, float alpha, float& l_reg, bf16x8& pa0, bf16x8& pa1, bf16x8& pa2, bf16x8& pa3) {
  for (int r = 0; r < 16; ++r) p1[r] = __builtin_amdgcn_exp2f(p1[r]);
  float ps = 0; for (int r = 0; r < 16; ++r) ps += p0[r]; for (int r = 0; r < 16; ++r) ps += p1[r];
  { auto rr = __builtin_amdgcn_permlane32_swap(__float_as_uint(ps), __float_as_uint(ps), false, false);
    ps = __uint_as_float(rr[0]) + __uint_as_float(rr[1]); }
  l_reg = l_reg * alpha + ps;
#define PK4(P, BASE, OUT) do { unsigned a0 = cvtpk(P[BASE + 0], P[BASE + 1]), a1 = cvtpk(P[BASE + 2], P[BASE + 3]);   \
    unsigned b0 = cvtpk(P[BASE + 4], P[BASE + 5]), b1 = cvtpk(P[BASE + 6], P[BASE + 7]);                              \
    auto r0 = __builtin_amdgcn_permlane32_swap(a0, b0, false, false); auto r1 = __builtin_amdgcn_permlane32_swap(a1, b1, false, false); \
    u32x4 w = {r0[0], r1[0], r0[1], r1[1]}; OUT = *reinterpret_cast<bf16x8*>(&w); } while (0)
  PK4(p0, 0, pa0); PK4(p0, 8, pa1); PK4(p1, 0, pa2); PK4(p1, 8, pa3);
#undef PK4
}
__device__ __forceinline__ void qkt(f32x16& p0, f32x16& p1, const bf16* Ks, const bf16x8* qr, int r32, int hi) {
  p0 = f32x16{}; p1 = f32x16{};
  for (int d0 = 0; d0 < 8; ++d0) { int cb = (d0 * 16 + hi * 8) * 2;
    bf16x8 b0 = *reinterpret_cast<const bf16x8*>((const char*)Ks + KSWZ(r32, cb));
    bf16x8 b1 = *reinterpret_cast<const bf16x8*>((const char*)Ks + KSWZ(32 + r32, cb));
    p0 = __builtin_amdgcn_mfma_f32_32x32x16_bf16(b0, qr[d0], p0, 0, 0, 0);
    p1 = __builtin_amdgcn_mfma_f32_32x32x16_bf16(b1, qr[d0], p1, 0, 0, 0); }
}
__device__ __forceinline__ int v_st(int k, int c) { const int kk = (k & ~0xC) | ((k & 4) << 1) | ((k & 8) >> 1); return ((kk >> 3) * 4 + (c >> 5)) * 512 + ((kk & 7) * 32 + (c & 31)) * 2; }
__device__ __forceinline__ int v_rd_base(int lane) { return ((lane & 3) << 3) | (((lane >> 2) & 3) << 6) | (((lane >> 4) & 1) << 5) | (((lane >> 5) & 1) << 8); }
constexpr int v_rd_off(int d0, int ks, int half) { return d0 * 512 + ks * 4096 + half * 2048; }
template <int OFF> __device__ __forceinline__ s16x4 tr_read(int vb) {
  s16x4 r; asm volatile("ds_read_b64_tr_b16 %0, %1 offset:%2" : "=&v"(r) : "v"(vb), "i"(OFF) : "memory"); return r;
}
template <int D0> __device__ __forceinline__ void pv_one(f32x16& od, int vb, bf16x8 pa0, bf16x8 pa1, bf16x8 pa2, bf16x8 pa3) {
  const s16x4 l0 = tr_read<v_rd_off(D0, 0, 0)>(vb), h0 = tr_read<v_rd_off(D0, 0, 1)>(vb), l1 = tr_read<v_rd_off(D0, 1, 0)>(vb), h1 = tr_read<v_rd_off(D0, 1, 1)>(vb);
  const s16x4 l2 = tr_read<v_rd_off(D0, 2, 0)>(vb), h2 = tr_read<v_rd_off(D0, 2, 1)>(vb), l3 = tr_read<v_rd_off(D0, 3, 0)>(vb), h3 = tr_read<v_rd_off(D0, 3, 1)>(vb);
  asm volatile("s_waitcnt lgkmcnt(0)" ::: "memory"); SBAR();
#define PK(L, H) (bf16x8){L[0], L[1], L[2], L[3], H[0], H[1], H[2], H[3]}
  od = __builtin_amdgcn_mfma_f32_32x32x16_bf16(pa0, PK(l0, h0), od, 0, 0, 0);
  od = __builtin_amdgcn_mfma_f32_32x32x16_bf16(pa1, PK(l1, h1), od, 0, 0, 0);
  od = __builtin_amdgcn_mfma_f32_32x32x16_bf16(pa2, PK(l2, h2), od, 0, 0, 0);
  od = __builtin_amdgcn_mfma_f32_32x32x16_bf16(pa3, PK(l3, h3), od, 0, 0, 0);
#undef PK
}
__device__ __forceinline__ void pv_d0(f32x16* o, int vb, bf16x8 pa0, bf16x8 pa1, bf16x8 pa2, bf16x8 pa3) {
  pv_one<0>(o[0], vb, pa0, pa1, pa2, pa3); pv_one<1>(o[1], vb, pa0, pa1, pa2, pa3); pv_one<2>(o[2], vb, pa0, pa1, pa2, pa3); pv_one<3>(o[3], vb, pa0, pa1, pa2, pa3);
}

__device__ __forceinline__ void attn_dense_body(const bf16* __restrict__ Qb, const bf16* __restrict__ Kh, const bf16* __restrict__ Vh, bf16* __restrict__ Ob, int seq, char* lds, const int tid) {
  const int wid = tid >> 6, lane = tid & 63, r32 = lane & 31, hi = lane >> 5;
  bf16* V_lds = (bf16*)lds; bf16* K_lds = (bf16*)(lds + 2 * SHM_V);
  float* ws = (float*)(lds + 2 * SHM_V + 2 * SHM_K) + wid * 64; float* li_l = ws; float* al_l = ws + 32;
  float m_reg = -1e30f, l_reg = 0; f32x16 o[4] = {}; bf16x8 qr[8];
  const bf16* Qw = Qb + (long)(wid * QBLK + r32) * LDQ + hi * 8;
#pragma unroll
  for (int d0 = 0; d0 < 8; ++d0) qr[d0] = ld8(Qw + d0 * 16);
  const int sr = tid >> 4, sc = (tid & 15) * 8, vst0 = v_st(sr, sc), vst1 = v_st(32 + sr, sc);
  const int vb0 = (int)(uintptr_t)V_lds + v_rd_base(lane);
  struct { bf16x8 vs0, vs1, ks0, ks1; } sr_[SDEPTH];
#define SLOAD(i, k0) do { sr_[i].vs0 = ld8(&Vh[(long)((k0) + sr) * LDK + sc]); sr_[i].vs1 = ld8(&Vh[(long)((k0) + 32 + sr) * LDK + sc]); \
    sr_[i].ks0 = ld8(&Kh[(long)((k0) + sr) * LDK + sc]); sr_[i].ks1 = ld8(&Kh[(long)((k0) + 32 + sr) * LDK + sc]); } while (0)
#define SWRITE(b, i) do { *(bf16x8*)((char*)V_lds + (b) * SHM_V + vst0) = sr_[i].vs0;          \
    *(bf16x8*)((char*)V_lds + (b) * SHM_V + vst1) = sr_[i].vs1; int kc = sc * 2;               \
    *(bf16x8*)((char*)K_lds + (b) * SHM_K + KSWZ(sr, kc)) = sr_[i].ks0;                       \
    *(bf16x8*)((char*)K_lds + (b) * SHM_K + KSWZ(32 + sr, kc)) = sr_[i].ks1; } while (0)
#define SWAIT() do { if constexpr (SDEPTH == 2) asm volatile("s_waitcnt vmcnt(4)" ::: "memory"); else asm volatile("s_waitcnt vmcnt(0)" ::: "memory"); } while (0)
#define RESC(a) do { if (__any((a) < 1.f)) { if (hi == 0) al_l[r32] = (a); asm volatile("s_waitcnt lgkmcnt(0)" ::: "memory"); \
    for (int d = 0; d < 4; ++d) for (int r = 0; r < 16; ++r) o[d][r] *= al_l[crow(r, hi)]; } } while (0)
  f32x16 pA0, pA1, pB0, pB1; float mnA, mnB, alA, alB; bf16x8 pa0, pa1, pa2, pa3; const int NT = seq / KVBLK;
  constexpr int SE = 0, SO = SDEPTH - 1;
  SLOAD(SE, 0); asm volatile("s_waitcnt vmcnt(0)" ::: "memory"); SWRITE(0, SE); __syncthreads();
  qkt(pA0, pA1, K_lds, qr, r32, hi); partialSM(pA0, pA1, m_reg, mnA, alA);
  SLOAD(SO, KVBLK); if constexpr (SDEPTH == 2) { if (2 < NT) SLOAD(SE, 2 * KVBLK); }
  SWAIT(); SWRITE(1, SO); __syncthreads();
  for (int j = 1; j + 1 < NT; j += 2) {
    SBAR(); qkt(pB0, pB1, (bf16*)((char*)K_lds + SHM_K), qr, r32, hi);
    finishSM(pA0, pA1, alA, l_reg, pa0, pa1, pa2, pa3); SBAR();
    SLOAD(SO, (j + SDEPTH) * KVBLK); SBAR();
    pv_d0(o, vb0, pa0, pa1, pa2, pa3); partialSM(pB0, pB1, m_reg, mnB, alB);
    __syncthreads(); SWAIT(); SWRITE(0, SE);
    RESC(alB); __syncthreads();
    SBAR(); qkt(pA0, pA1, K_lds, qr, r32, hi);
    finishSM(pB0, pB1, alB, l_reg, pa0, pa1, pa2, pa3); SBAR();
    if (SDEPTH == 1 || j + 3 < NT) SLOAD(SE, (j + 1 + SDEPTH) * KVBLK); SBAR();
    pv_d0(o, vb0 + (int)SHM_V, pa0, pa1, pa2, pa3); partialSM(pA0, pA1, m_reg, mnA, alA);
    __syncthreads(); SWAIT(); SWRITE(1, SO);
    RESC(alA); __syncthreads();
  }
  SBAR(); qkt(pB0, pB1, (bf16*)((char*)K_lds + SHM_K), qr, r32, hi);
  finishSM(pA0, pA1, alA, l_reg, pa0, pa1, pa2, pa3); SBAR();
  pv_d0(o, vb0, pa0, pa1, pa2, pa3); partialSM(pB0, pB1, m_reg, mnB, alB);
  __syncthreads(); RESC(alB);
  finishSM(pB0, pB1, alB, l_reg, pa0, pa1, pa2, pa3); SBAR();
  pv_d0(o, vb0 + (int)SHM_V, pa0, pa1, pa2, pa3);
  if (hi == 0) li_l[r32] = l_reg; asm volatile("s_waitcnt lgkmcnt(0)" ::: "memory");
  float rli[16];
#pragma unroll
  for (int r = 0; r < 16; ++r) rli[r] = __builtin_amdgcn_rcpf(li_l[crow(r, hi)]);
  bf16* Ow = Ob + (long)(wid * QBLK) * LDO;
#pragma unroll
  for (int r = 0; r < 16; r += 2) {
#pragma unroll
    for (int d0 = 0; d0 < 4; ++d0) {
      const float a = o[d0][r] * rli[r], b = o[d0][r + 1] * rli[r + 1];
      const float send = (lane & 1) ? a : b; const float recv = __shfl_xor(send, 1);
      const unsigned w = (lane & 1) ? cvtpk(recv, b) : cvtpk(a, recv);
      const int orow = crow(r, hi) + (lane & 1), ocol = d0 * 32 + (r32 & ~1);
      *(unsigned*)(Ow + (long)orow * LDO + ocol) = w; } }
#undef SLOAD
#undef SWRITE
#undef SWAIT
#undef RESC
}
}

struct Args { const float* in[21]; float* out; unsigned char* ws; int ph_lo, ph_hi; };
static_assert(sizeof(Args) == 23 * 8 + 8, "Args has no padding");
template <int OFF> __device__ __forceinline__ unsigned long long karg64() {
    unsigned long long v; const unsigned long long kp = (unsigned long long)__builtin_amdgcn_kernarg_segment_ptr();
    asm volatile("s_load_dwordx2 %0, %1, %2\n\ts_waitcnt lgkmcnt(0)" : "=s"(v) : "s"(kp), "i"(OFF) : "memory"); return v;
}
#define KIN(i) ((const float*)(const GAS float*)karg64<8 * (i)>())
#define KOUT() ((float*)(GAS float*)karg64<168>())
#define KWS() ((unsigned char*)(GAS unsigned char*)karg64<176>())

struct Ctx { int tid, lane, wave, G, vcu, gw, NGW; LAS unsigned char* lds; };

__device__ __forceinline__ void transpose_item(const float* W, int K, int N, bf16* WT, int k0, int n0, int drow0, LAS float* scr, int lane) {
#pragma unroll 8
    for (int i = 0; i < 32; ++i) { const int kk = 2 * i + (lane >> 5); scr[kk * 33 + (lane & 31)] = W[(size_t)(k0 + kk) * N + n0 + (lane & 31)]; }
    asm volatile("s_waitcnt lgkmcnt(0)" ::: "memory");
    const int c = lane & 7;
#pragma unroll
    for (int j = 0; j < 4; ++j) { const int n = (lane >> 3) + 8 * j; const LAS float* s = scr + (8 * c) * 33 + n;
        u32x4 o; o.x = cvt_pk_bf16(s[0 * 33], s[1 * 33]); o.y = cvt_pk_bf16(s[2 * 33], s[3 * 33]); o.z = cvt_pk_bf16(s[4 * 33], s[5 * 33]); o.w = cvt_pk_bf16(s[6 * 33], s[7 * 33]);
        *(u32x4*)(WT + (size_t)(drow0 + n) * K + k0 + 8 * c) = o; }
    asm volatile("s_waitcnt lgkmcnt(0)" ::: "memory");
}
__device__ __forceinline__ int gu_row(int n0) { return ((n0 & 255) >> 7) * 256 + ((n0 >> 8) << 7) + (n0 & 127); }
__device__ __forceinline__ int tok_row(int l, int tt) { return l == 0 ? tt : (tt >> 12) * RPB + CTXL + (tt & 4095); }

__device__ __forceinline__ void ph_prologue(const Ctx& F) {
    unsigned char* ws = KWS();
    float* MOD = (float*)(ws + WS_MOD); float* ROPE = (float*)(ws + WS_ROPE);
    LAS float* sl = (LAS float*)(F.lds);
    LAS float* red = (LAS float*)(F.lds + 40960);
    if ((int)blockIdx.x < 192 || F.G < 192) {
        const float* c_in = KIN(1); const float* cctx_in = KIN(3); const float* ada_w = KIN(4); const float* ada_b = KIN(5);
        for (int i = F.tid; i < 9 * 1024; i += 512) { const int r = i >> 10, k = i & 1023; const float v = r < 8 ? c_in[r * 1024 + k] : cctx_in[k]; sl[i] = v / (1.0f + expf(-v)); }
        __syncthreads();
        for (int grp = blockIdx.x; grp < 192; grp += F.G) {
            const int l = grp / 96, n0 = (grp % 96) * 64;
            const float* W = ada_w + (size_t)l * 1024 * 6144 + n0 + F.lane;
            float acc[9];
#pragma unroll
            for (int r = 0; r < 9; ++r) acc[r] = 0.f;
            const int kb = F.wave * 128;
#pragma unroll 8
            for (int k = 0; k < 128; ++k) { const float w = W[(size_t)(kb + k) * 6144];
#pragma unroll
                for (int r = 0; r < 9; ++r) acc[r] += sl[r * 1024 + kb + k] * w; }
#pragma unroll
            for (int r = 0; r < 9; ++r) red[(F.wave * 9 + r) * 64 + F.lane] = acc[r];
            __syncthreads();
            for (int i = F.tid; i < 576; i += 512) { const int r = i >> 6, ln = i & 63; float s = ada_b[l * 6144 + n0 + ln];
#pragma unroll
                for (int w = 0; w < 8; ++w) s += red[(w * 9 + r) * 64 + ln];
                MOD[(size_t)(l * 9 + r) * 6144 + n0 + ln] = s; }
            __syncthreads();
        }
    }
    __syncthreads();
    for (int idx = blockIdx.x * 512 + F.tid; idx < 4096 * 64; idx += F.G * 512) {
        const int t = idx >> 6, i = idx & 63; const int pos = i < 32 ? (t >> 6) : (t & 63); const int j = i & 31;
        const float freq = powf(10000.0f, -(float)(2 * j) / 64.0f); const float ang = (float)pos * freq;
        ROPE[2 * idx] = cosf(ang); ROPE[2 * idx + 1] = sinf(ang);
    }
    bf16* Wqkv_t = (bf16*)(ws + WS_WQKV); bf16* Wo_t = (bf16*)(ws + WS_WO); bf16* Win_t = (bf16*)(ws + WS_WIN); bf16* Wout_t = (bf16*)(ws + WS_WOUT);
    bf16* Wr_t = (bf16*)(ws + WS_WR); bf16* Wgu_t = (bf16*)(ws + WS_WGU); bf16* Wd_t = (bf16*)(ws + WS_WD);
    LAS float* scr = (LAS float*)(F.lds + F.wave * 16384);
    constexpr int I_QKV = 16 * 48, I_WO = 16 * 32, I_WIN = 16 * 96, I_WOUT = 16 * 32, I_R = 2 * 16 * 8, I_GU = 2 * 256 * 256, I_GUS = 2 * 256, I_D = 2 * 256 * 128, I_DS = 2 * 128;
    constexpr int NITEMS = I_QKV + I_WO + I_WIN + I_WOUT + I_R + I_GU + I_GUS + I_D + I_DS;
    for (int it = F.gw; it < NITEMS; it += F.NGW) {
        int r = it;
        if (r < I_QKV) { const int nblk = 48, kb = r / nblk, nb = r % nblk; transpose_item(KIN(8), 1024, 1536, Wqkv_t, 64 * kb, 32 * nb, 32 * nb, scr, F.lane); continue; } r -= I_QKV;
        if (r < I_WO) { const int nblk = 32, kb = r / nblk, nb = r % nblk; transpose_item(KIN(11), 1024, 1024, Wo_t, 64 * kb, 32 * nb, 32 * nb, scr, F.lane); continue; } r -= I_WO;
        if (r < I_WIN) { const int nblk = 96, kb = r / nblk, nb = r % nblk; transpose_item(KIN(12), 1024, 3072, Win_t, 64 * kb, 32 * nb, 32 * nb, scr, F.lane); continue; } r -= I_WIN;
        if (r < I_WOUT) { const int nblk = 32, kb = r / nblk, nb = r % nblk; transpose_item(KIN(14), 1024, 1024, Wout_t, 64 * kb, 32 * nb, 32 * nb, scr, F.lane); continue; } r -= I_WOUT;
        if (r < I_R) { const int l = r / 128, q = r % 128, kb = q / 8, nb = q % 8; transpose_item(KIN(15) + (size_t)l * 1024 * 256, 1024, 256, Wr_t + (size_t)l * 256 * 1024, 64 * kb, 32 * nb, 32 * nb, scr, F.lane); continue; } r -= I_R;
        if (r < I_GU) { const int mat = r / 256, q = r % 256, kb = q / 16, nb = q % 16, l = mat / 256, e = mat % 256;
            transpose_item(KIN(17) + (size_t)mat * 1024 * 512, 1024, 512, Wgu_t + (size_t)(l * 257 + e) * 512 * 1024, 64 * kb, 32 * nb, gu_row(32 * nb), scr, F.lane); continue; } r -= I_GU;
        if (r < I_GUS) { const int l = r / 256, q = r % 256, kb = q / 16, nb = q % 16;
            transpose_item(KIN(19) + (size_t)l * 1024 * 512, 1024, 512, Wgu_t + (size_t)(l * 257 + 256) * 512 * 1024, 64 * kb, 32 * nb, gu_row(32 * nb), scr, F.lane); continue; } r -= I_GUS;
        if (r < I_D) { const int mat = r / 128, q = r % 128, kb = q / 32, nb = q % 32, l = mat / 256, e = mat % 256;
            transpose_item(KIN(18) + (size_t)mat * 256 * 1024, 256, 1024, Wd_t + (size_t)(l * 257 + e) * 1024 * 256, 64 * kb, 32 * nb, 32 * nb, scr, F.lane); continue; } r -= I_D;
        { const int l = r / 128, q = r % 128, kb = q / 32, nb = q % 32;
            transpose_item(KIN(20) + (size_t)l * 256 * 1024, 256, 1024, Wd_t + (size_t)(l * 257 + 256) * 1024 * 256, 64 * kb, 32 * nb, 32 * nb, scr, F.lane); }
    }
}

__device__ __forceinline__ void ph_modulate0(const Ctx& F) {
    unsigned char* ws = KWS(); const float* MOD = (const float*)(ws + WS_MOD); bf16* HX = (bf16*)(ws + WS_HX);
    const float* x_in = KIN(0); const float* ctx_in = KIN(2);
    for (int m = F.gw; m < MROWS; m += F.NGW) {
        const int b = m / RPB, j = m % RPB;
        const float* src = j < CTXL ? ctx_in + (size_t)(b * CTXL + j) * DM : x_in + (size_t)(b * SEQ + j - CTXL) * DM;
        const float* md = MOD + (size_t)(j < CTXL ? 8 : b) * 6144;
        unsigned long long* o8 = (unsigned long long*)(HX + (size_t)m * DM) + F.lane;
#pragma unroll
        for (int q = 0; q < 4; ++q) { const int c = 4 * F.lane + 256 * q; const f32x4 v = *(const f32x4*)(src + c), sh = *(const f32x4*)(md + c), sc = *(const f32x4*)(md + 1024 + c);
            const f32x4 h = v * (sc + 1.0f) + sh;
            o8[64 * q] = (unsigned long long)cvt_pk_bf16(h[0], h[1]) | ((unsigned long long)cvt_pk_bf16(h[2], h[3]) << 32); }
    }
}

__device__ __forceinline__ void ph_gemm_in(const Ctx& F, int l) {
    unsigned char* ws = KWS();
    const int N = l == 0 ? NQKV : NWIN;
    pg8::DenseOrder S; S.init(l == 0 ? MROWS / 256 : TL1 / 256, N / 256, F.G, (int)blockIdx.x, l, ws + WS_HX, ws + (l == 0 ? WS_WQKV : WS_WIN), DM);
    pg8::EpiBf16 E{(bf16*)(ws + WS_QKV), N};
    pg8::gemm_phase<pg8::EpiBf16, pg8::DenseOrder, false>(F.lds, S, E, DM, F.tid);
}
__device__ __forceinline__ void ph_gemm_out(const Ctx& F, int l) {
    unsigned char* ws = KWS();
    pg8::DenseOrder S; S.init(l == 0 ? MROWS / 256 : TL1 / 256, DM / 256, F.G, (int)blockIdx.x, l, ws + WS_O, ws + (l == 0 ? WS_WO : WS_WOUT), DM);
    pg8::EpiBf16 E{(bf16*)(ws + WS_Y), DM};
    pg8::gemm_phase<pg8::EpiBf16, pg8::DenseOrder, false>(F.lds, S, E, DM, F.tid);
}
__device__ __forceinline__ void ph_router(const Ctx& F, int l) {
    unsigned char* ws = KWS();
    pg8::DenseOrder S; S.init(l == 0 ? MROWS / 256 : TL1 / 256, 1, F.G, (int)blockIdx.x, l, ws + WS_H2, ws + WS_WR + (size_t)l * 256 * 1024 * 2, DM);
    pg8::EpiF32 E{(float*)(ws + WS_LOG), NE};
    pg8::gemm_phase<pg8::EpiF32, pg8::DenseOrder, false>(F.lds, S, E, DM, F.tid);
}

__device__ __forceinline__ void ph_normrope(const Ctx& F) {
    unsigned char* ws = KWS(); const float* ROPE = (const float*)(ws + WS_ROPE); bf16* QKV = (bf16*)(ws + WS_QKV);
    const float* qg = KIN(9); const float* kg = KIN(10);
    const float2 gq = *(const float2*)(qg + 2 * F.lane), gk = *(const float2*)(kg + 2 * F.lane);
    for (int m = F.gw; m < MROWS; m += F.NGW) {
        const int j = m % RPB; const bool lat = j >= CTXL; const int t = j - CTXL;
        float cs = 1.f, sn = 0.f; if (lat) { const float2 r = *(const float2*)(ROPE + 2 * (t * 64 + F.lane)); cs = r.x; sn = r.y; }
        unsigned* row = (unsigned*)(QKV + (size_t)m * NQKV);
#pragma unroll
        for (int hh = 0; hh < NH + NKV; ++hh) {
            const unsigned w = row[hh * 64 + F.lane]; const float v0 = bf_lo(w), v1 = bf_hi(w);
            const float ss = wave_sum(v0 * v0 + v1 * v1);
            const float rs = 1.0f / sqrtf(ss * (1.0f / 128.0f) + QK_EPS);
            const float g0 = hh < NH ? gq.x : gk.x, g1 = hh < NH ? gq.y : gk.y;
            const float a0 = v0 * rs * g0, a1 = v1 * rs * g1;
            row[hh * 64 + F.lane] = cvt_pk_bf16(a0 * cs - a1 * sn, a0 * sn + a1 * cs);
        }
    }
}
__device__ __forceinline__ void ph_conv(const Ctx& F) {
    unsigned char* ws = KWS(); const bf16* QKV = (const bf16*)(ws + WS_QKV); bf16* OB = (bf16*)(ws + WS_O);
    const float* taps = KIN(13);
    for (int tt = F.gw; tt < TL1; tt += F.NGW) {
        const int m = tok_row(1, tt), s = tt & 4095;
        const bf16* r0 = QKV + (size_t)m * NWIN;
        unsigned long long* o8 = (unsigned long long*)(OB + (size_t)m * DM) + F.lane;
#pragma unroll
        for (int q = 0; q < 4; ++q) { const int c = 4 * F.lane + 256 * q;
            const u32x2 bg = *(const u32x2*)(r0 + c);
            f32x4 cv = (f32x4){0.f, 0.f, 0.f, 0.f};
#pragma unroll
            for (int d = -1; d <= 1; ++d) { if (s + d < 0 || s + d >= SEQ) continue;
                const bf16* rr = r0 + (long)d * NWIN; const u32x2 cg = *(const u32x2*)(rr + DM + c), vv = *(const u32x2*)(rr + 2 * DM + c);
                const f32x4 tp = *(const f32x4*)(taps + (d + 1) * DM + c);
                cv[0] += bf_lo(cg.x) * bf_lo(vv.x) * tp[0]; cv[1] += bf_hi(cg.x) * bf_hi(vv.x) * tp[1]; cv[2] += bf_lo(cg.y) * bf_lo(vv.y) * tp[2]; cv[3] += bf_hi(cg.y) * bf_hi(vv.y) * tp[3]; }
            o8[64 * q] = (unsigned long long)cvt_pk_bf16(bf_lo(bg.x) * cv[0], bf_hi(bg.x) * cv[1]) | ((unsigned long long)cvt_pk_bf16(bf_lo(bg.y) * cv[2], bf_hi(bg.y) * cv[3]) << 32); }
    }
}
__device__ __forceinline__ void ph_attention(const Ctx& F, unsigned char* lds_generic) {
    unsigned char* ws = KWS(); const bf16* QKV = (const bf16*)(ws + WS_QKV); bf16* OB = (bf16*)(ws + WS_O);
    for (int L = F.vcu; L < 1024 + 64; L += F.G) {
        int pair, hl, qb;
        if (L < 1024) { pair = (L & 255) / 32 + 8 * ((L >> 8) >> 1); const int u = ((L >> 8) & 1) * 32 + (L & 31); hl = u >> 4; qb = 1 + (u & 15); }
        else { const int s = L - 1024; pair = s >> 2; hl = s & 3; qb = 0; }
        const int b = pair >> 1, kvh = pair & 1, h = kvh * 4 + hl;
        const bf16* base = QKV + (size_t)b * RPB * NQKV;
        __syncthreads();
        att::attn_dense_body(base + (size_t)(qb * 256) * NQKV + h * HD, base + NH * HD + kvh * HD, base + (NH + NKV) * HD + kvh * HD,
                             OB + (size_t)(b * RPB + qb * 256) * DM + h * HD, qb == 0 ? CTXL : RPB, (char*)lds_generic, F.tid);
    }
}
__device__ __forceinline__ void ph_ln1(const Ctx& F, int l) {
    unsigned char* ws = KWS(); const float* md_l = (const float*)(ws + WS_MOD) + (size_t)l * 9 * 6144;
    const bf16* YB = (const bf16*)(ws + WS_Y); float* X1 = (float*)(ws + WS_X1); bf16* H2 = (bf16*)(ws + WS_H2); const float* X2 = (const float*)(ws + WS_X2);
    const float* x_in = KIN(0); const float* ctx_in = KIN(2);
    const float* lg = KIN(6) + (size_t)(l * 2 + 0) * DM; const float* lb = KIN(7) + (size_t)(l * 2 + 0) * DM;
    const int TL = l == 0 ? TL0 : TL1;
    for (int tt = F.gw; tt < TL; tt += F.NGW) {
        const int m = tok_row(l, tt), b = m / RPB, j = m % RPB;
        const float* xr = l == 0 ? (j < CTXL ? ctx_in + (size_t)(b * CTXL + j) * DM : x_in + (size_t)(b * SEQ + j - CTXL) * DM) : X2 + (size_t)m * DM;
        const float* md = md_l + (size_t)(j < CTXL ? 8 : b) * 6144;
        const bf16* yr = YB + (size_t)m * DM;
        f32x4 v[4]; float s = 0.f;
#pragma unroll
        for (int q = 0; q < 4; ++q) { const int c = 4 * F.lane + 256 * q; const f32x4 xv = *(const f32x4*)(xr + c), g = *(const f32x4*)(md + 2 * 1024 + c); const u32x2 yw = *(const u32x2*)(yr + c);
            v[q] = xv * DN_ALPHA + g * (f32x4){bf_lo(yw.x), bf_hi(yw.x), bf_lo(yw.y), bf_hi(yw.y)}; s += (v[q][0] + v[q][1]) + (v[q][2] + v[q][3]); }
        const float mean = wave_sum(s) * (1.f / DM); float s2 = 0.f;
#pragma unroll
        for (int q = 0; q < 4; ++q) { v[q] = v[q] - mean; s2 += (v[q][0] * v[q][0] + v[q][1] * v[q][1]) + (v[q][2] * v[q][2] + v[q][3] * v[q][3]); }
        const float rstd = 1.f / sqrtf(wave_sum(s2) * (1.f / DM) + LN_EPS);
        unsigned long long* o8 = (unsigned long long*)(H2 + (size_t)m * DM) + F.lane;
#pragma unroll
        for (int q = 0; q < 4; ++q) { const int c = 4 * F.lane + 256 * q; const f32x4 o = v[q] * rstd * *(const f32x4*)(lg + c) + *(const f32x4*)(lb + c);
            *(f32x4*)(X1 + (size_t)m * DM + c) = o;
            const f32x4 h = o * (*(const f32x4*)(md + 4 * 1024 + c) + 1.0f) + *(const f32x4*)(md + 3 * 1024 + c);
            o8[64 * q] = (unsigned long long)cvt_pk_bf16(h[0], h[1]) | ((unsigned long long)cvt_pk_bf16(h[2], h[3]) << 32); }
    }
}
__device__ __forceinline__ void ph_routing(const Ctx& F, int l) {
    unsigned char* ws = KWS(); const float* LOG = (const float*)(ws + WS_LOG); int* EIDX = (int*)(ws + WS_EIDX); float* GATE = (float*)(ws + WS_GATE);
    unsigned* cnt = (unsigned*)(ws + WS_CTL) + CW_CNT + l * 256;
    const float* rb = KIN(16) + l * NE;
    const f32x4 bs = *(const f32x4*)(rb + 4 * F.lane);
    const int TL = l == 0 ? TL0 : TL1;
    for (int tt = F.gw; tt < TL; tt += F.NGW) {
        const int m = tok_row(l, tt);
        const f32x4 lgv = *(const f32x4*)(LOG + (size_t)m * NE + 4 * F.lane);
        float sc[4], mv[4];
#pragma unroll
        for (int j = 0; j < 4; ++j) { sc[j] = 1.0f / (1.0f + expf(-lgv[j])); mv[j] = sc[j] + bs[j]; }
        float a = fmaxf(fmaxf(mv[0], mv[1]), fmaxf(mv[2], mv[3]));
        float bq; { const float m01 = fmaxf(mv[0], mv[1]), n01 = fminf(mv[0], mv[1]), m23 = fmaxf(mv[2], mv[3]), n23 = fminf(mv[2], mv[3]); bq = fmaxf(fminf(m01, m23), fmaxf(n01, n23)); }
#pragma unroll
        for (int off = 1; off < 8; off <<= 1) { const float a2 = __shfl_xor(a, off), b2 = __shfl_xor(bq, off); const float na = fmaxf(a, a2), nb = fmaxf(fminf(a, a2), fmaxf(bq, b2)); a = na; bq = nb; }
        const float gs = a + bq; const int myg = F.lane >> 3; int rank = 0;
#pragma unroll
        for (int g = 0; g < 8; ++g) { const float og = __shfl(gs, g * 8); rank += (og > gs || (og == gs && g < myg)) ? 1 : 0; }
        if (rank >= 4) { mv[0] = mv[1] = mv[2] = mv[3] = -INFINITY; }
        int my_e = 0; float my_s = 0.f, gsum = 0.f;
#pragma unroll
        for (int k = 0; k < TOPK; ++k) {
            float bv = mv[0]; int bi = 0;
#pragma unroll
            for (int j = 1; j < 4; ++j) if (mv[j] > bv) { bv = mv[j]; bi = j; }
            float cv = bv; int ci = 4 * F.lane + bi;
#pragma unroll
            for (int off = 32; off >= 1; off >>= 1) { const float ov = __shfl_xor(cv, off); const int oi = __shfl_xor(ci, off); if (ov > cv || (ov == cv && oi < ci)) { cv = ov; ci = oi; } }
            const bool mine = (ci >> 2) == F.lane; const int wj = ci & 3;
            const float ssel = wj == 0 ? sc[0] : wj == 1 ? sc[1] : wj == 2 ? sc[2] : sc[3];
            if (mine) {
#pragma unroll
                for (int j = 0; j < 4; ++j) if (wj == j) mv[j] = -INFINITY; }
            const float sw = __shfl(ssel, ci >> 2);
            gsum += sw;
            if (F.lane == k) { my_e = ci; my_s = sw; }
        }
        if (F.lane < TOPK) { EIDX[(size_t)m * 8 + F.lane] = my_e; GATE[(size_t)m * 8 + F.lane] = my_s / gsum * ROUTED_SCALE; atomicAdd(&cnt[my_e], 1u); }
    }
}
__device__ __forceinline__ void build_tables(const Ctx& F, int l) {
    unsigned char* ws = KWS(); unsigned* cnt = (unsigned*)(ws + WS_CTL) + CW_CNT + l * 256;
    LAS int* tstart = (LAS int*)(F.lds + TBL_OFF); LAS int* tmp = (LAS int*)(F.lds + TBL_TMP); LAS unsigned short* texp = (LAS unsigned short*)(F.lds + TBL_EXP);
    const int TL = l == 0 ? TL0 : TL1;
    __syncthreads();
    if (F.tid < NE) tmp[F.tid] = ((int)__hip_atomic_load(&cnt[F.tid], __ATOMIC_RELAXED, __HIP_MEMORY_SCOPE_AGENT) + 255) >> 8;
    __syncthreads();
    if (F.tid <= NE) { int s = 0; for (int e = 0; e < F.tid; ++e) s += tmp[e]; tstart[F.tid] = s; }
    __syncthreads();
    const int nrt = tstart[NE];
    if (F.tid < NE) { for (int t = tstart[F.tid]; t < tstart[F.tid + 1]; ++t) texp[t] = (unsigned short)F.tid; }
    for (int t = nrt + F.tid; t < nrt + TL / 256; t += 512) texp[t] = (unsigned short)NE;
    __syncthreads();
}
__device__ __forceinline__ void ph_scatter(const Ctx& F, int l) {
    unsigned char* ws = KWS(); const int* EIDX = (const int*)(ws + WS_EIDX); int* POS = (int*)(ws + WS_POS); int* TOK = (int*)(ws + WS_TOK);
    unsigned* cnt = (unsigned*)(ws + WS_CTL) + CW_CNT + l * 256; unsigned* fill = (unsigned*)(ws + WS_CTL) + CW_FILL + l * 256;
    const LAS int* tstart = (const LAS int*)(F.lds + TBL_OFF);
    const int TL = l == 0 ? TL0 : TL1; const int nrt = tstart[NE];
    for (int idx = blockIdx.x * 512 + F.tid; idx < TL * 8; idx += F.G * 512) {
        const int tt = idx >> 3, k = idx & 7, m = tok_row(l, tt);
        const int e = EIDX[(size_t)m * 8 + k];
        const int p = tstart[e] * 256 + (int)atomicAdd(&fill[e], 1u);
        TOK[p] = m; POS[(size_t)m * 9 + k] = p;
    }
    for (int tt = blockIdx.x * 512 + F.tid; tt < TL; tt += F.G * 512) { const int m = tok_row(l, tt), p = nrt * 256 + tt; TOK[p] = m; POS[(size_t)m * 9 + 8] = p; }
    for (int e = blockIdx.x; e < NE; e += F.G) {
        const int c = (int)__hip_atomic_load(&cnt[e], __ATOMIC_RELAXED, __HIP_MEMORY_SCOPE_AGENT);
        for (int p = tstart[e] * 256 + c + F.tid; p < tstart[e + 1] * 256; p += 512) TOK[p] = tok_row(l, 0);
    }
}
__device__ __forceinline__ void ph_gemm1(const Ctx& F, int l) {
    unsigned char* ws = KWS(); const LAS int* tstart = (const LAS int*)(F.lds + TBL_OFF);
    const int ntiles = tstart[NE] + (l == 0 ? TL0 : TL1) / 256;
    pg8::ExpertOrder<1> S; S.nunits = ntiles * 2; S.G = F.G; S.c = F.vcu; S.texp = (const LAS unsigned short*)(F.lds + TBL_EXP);
    S.A = (const char*)(ws + WS_H2); S.Bt = (const char*)(ws + WS_WGU) + (size_t)l * 257 * 512 * 1024 * 2; S.toks = (const int*)(ws + WS_TOK); S.a_tstep = 0; S.b_tstep = 256u * 1024u * 2u;
    pg8::EpiSwiGLU E{(bf16*)(ws + WS_ACT)};
    pg8::gemm_phase<pg8::EpiSwiGLU, pg8::ExpertOrder<1>, true>(F.lds, S, E, DM, F.tid);
}
__device__ __forceinline__ void ph_gemm2(const Ctx& F, int l) {
    unsigned char* ws = KWS(); const LAS int* tstart = (const LAS int*)(F.lds + TBL_OFF);
    const int ntiles = tstart[NE] + (l == 0 ? TL0 : TL1) / 256;
    pg8::ExpertOrder<2> S; S.nunits = ntiles * 4; S.G = F.G; S.c = F.vcu; S.texp = (const LAS unsigned short*)(F.lds + TBL_EXP);
    S.A = (const char*)(ws + WS_ACT); S.Bt = (const char*)(ws + WS_WD) + (size_t)l * 257 * 1024 * 256 * 2; S.toks = nullptr; S.a_tstep = 256u * EFF * 2u; S.b_tstep = 256u * EFF * 2u;
    pg8::EpiBf16 E{(bf16*)(ws + WS_YS), DM};
    pg8::gemm_phase<pg8::EpiBf16, pg8::ExpertOrder<2>, false>(F.lds, S, E, EFF, F.tid);
}
__device__ __forceinline__ void ph_ln2(const Ctx& F, int l) {
    unsigned char* ws = KWS(); const float* MOD = (const float*)(ws + WS_MOD); const float* md_l = MOD + (size_t)l * 9 * 6144;
    const float* X1 = (const float*)(ws + WS_X1); const bf16* YS = (const bf16*)(ws + WS_YS); const int* POS = (const int*)(ws + WS_POS); const float* GATE = (const float*)(ws + WS_GATE);
    float* X2 = (float*)(ws + WS_X2); bf16* HX = (bf16*)(ws + WS_HX); float* outp = KOUT();
    const float* lg = KIN(6) + (size_t)(l * 2 + 1) * DM; const float* lb = KIN(7) + (size_t)(l * 2 + 1) * DM;
    const int TL = l == 0 ? TL0 : TL1;
    for (int tt = F.gw; tt < TL; tt += F.NGW) {
        const int m = tok_row(l, tt), b = m / RPB, j = m % RPB;
        const float* md = md_l + (size_t)(j < CTXL ? 8 : b) * 6144;
        f32x4 acc[4];
#pragma unroll
        for (int q = 0; q < 4; ++q) acc[q] = (f32x4){0.f, 0.f, 0.f, 0.f};
#pragma unroll
        for (int k = 0; k < 9; ++k) { const int p = POS[(size_t)m * 9 + k]; const float g = k < 8 ? GATE[(size_t)m * 8 + k] : 1.0f; const bf16* yr = YS + (size_t)p * DM;
#pragma unroll
            for (int q = 0; q < 4; ++q) { const u32x2 yw = *(const u32x2*)(yr + 4 * F.lane + 256 * q); acc[q] += (f32x4){bf_lo(yw.x), bf_hi(yw.x), bf_lo(yw.y), bf_hi(yw.y)} * g; } }
        f32x4 v[4]; float s = 0.f;
#pragma unroll
        for (int q = 0; q < 4; ++q) { const int c = 4 * F.lane + 256 * q; const f32x4 xv = *(const f32x4*)(X1 + (size_t)m * DM + c), g = *(const f32x4*)(md + 5 * 1024 + c);
            v[q] = xv * DN_ALPHA + g * acc[q]; s += (v[q][0] + v[q][1]) + (v[q][2] + v[q][3]); }
        const float mean = wave_sum(s) * (1.f / DM); float s2 = 0.f;
#pragma unroll
        for (int q = 0; q < 4; ++q) { v[q] = v[q] - mean; s2 += (v[q][0] * v[q][0] + v[q][1] * v[q][1]) + (v[q][2] * v[q][2] + v[q][3] * v[q][3]); }
        const float rstd = 1.f / sqrtf(wave_sum(s2) * (1.f / DM) + LN_EPS);
        if (l == 0) {
            const float* md1 = MOD + (size_t)(9 + b) * 6144;
            unsigned long long* o8 = (unsigned long long*)(HX + (size_t)m * DM) + F.lane;
#pragma unroll
            for (int q = 0; q < 4; ++q) { const int c = 4 * F.lane + 256 * q; const f32x4 o = v[q] * rstd * *(const f32x4*)(lg + c) + *(const f32x4*)(lb + c);
                *(f32x4*)(X2 + (size_t)m * DM + c) = o;
                if (j >= CTXL) { const f32x4 h = o * (*(const f32x4*)(md1 + 1024 + c) + 1.0f) + *(const f32x4*)(md1 + c);
                    o8[64 * q] = (unsigned long long)cvt_pk_bf16(h[0], h[1]) | ((unsigned long long)cvt_pk_bf16(h[2], h[3]) << 32); } }
        } else {
            float* orow = outp + (size_t)tt * DM;
#pragma unroll
            for (int q = 0; q < 4; ++q) { const int c = 4 * F.lane + 256 * q; *(f32x4*)(orow + c) = v[q] * rstd * *(const f32x4*)(lg + c) + *(const f32x4*)(lb + c); }
        }
    }
}

#ifndef PH_MASK
#define PH_MASK 0xFFFF
#endif
#define EN(i) (((PH_MASK) >> (i)) & 1)
__global__ void __launch_bounds__(512, 2) fwd(Args args) {
    extern __shared__ __attribute__((aligned(16))) unsigned char lds_raw[];
    Ctx F;
    F.lds = (LAS unsigned char*)lds_raw;
    F.tid = threadIdx.x; F.lane = F.tid & 63; F.wave = __builtin_amdgcn_readfirstlane(F.tid >> 6);
    F.G = gridDim.x; { const int bx = blockIdx.x; F.vcu = (F.G % 8 == 0) ? (bx % 8) * (F.G / 8) + bx / 8 : bx; }
    F.gw = blockIdx.x * 8 + F.wave; F.NGW = F.G * 8;
    volatile LAS unsigned* MISC = (volatile LAS unsigned*)(F.lds + MISC_OFF);
    if (F.tid < 64) MISC[F.tid] = 0u;
    __syncthreads();
    const int lo = args.ph_lo, hi = args.ph_hi;
    XcdBarrier bar; bar.bar = (unsigned*)(args.ws + WS_CTL) + CW_BAR; bar.x = 0; bar.st = MISC + 8;
    if (hi - lo > 1) bar = xcd_barrier_post((unsigned*)(args.ws + WS_CTL) + CW_BAR, MISC + 8);
#define IN(k) (lo <= (k) && (k) < hi)
#define SEAM(k) do { if (IN(k) && IN((k) + 1)) xcd_barrier(bar); } while (0)
#define FRESH() asm volatile("" : "+v"(F.tid), "+v"(F.lane))

    if (EN(0) && IN(0)) { FRESH(); ph_prologue(F); }
    SEAM(0);
    if (EN(1) && IN(1)) { FRESH(); ph_modulate0(F); }
    SEAM(1);
    for (int l = 0; l < 2; ++l) {
        const int P0 = 2 + 11 * l;
        if (EN(2) && IN(P0 + 0)) { FRESH(); ph_gemm_in(F, l); }
        SEAM(P0 + 0);
        if (EN(3) && IN(P0 + 1)) { FRESH(); if (l == 0) ph_normrope(F); else ph_conv(F); }
        SEAM(P0 + 1);
        if (l == 0) {
            if (EN(4) && IN(P0 + 2)) { FRESH(); ph_attention(F, lds_raw); }
            SEAM(P0 + 2);
        }
        if (EN(5) && IN(P0 + 3)) { FRESH(); ph_gemm_out(F, l); }
        SEAM(P0 + 3);
        if (EN(6) && IN(P0 + 4)) { FRESH(); ph_ln1(F, l); }
        SEAM(P0 + 4);
        if (EN(7) && IN(P0 + 5)) { FRESH(); ph_router(F, l); }
        SEAM(P0 + 5);
        if (EN(8) && IN(P0 + 6)) { FRESH(); ph_routing(F, l); }
        SEAM(P0 + 6);
        if ((EN(9) && IN(P0 + 7)) || (EN(10) && IN(P0 + 8)) || (EN(11) && IN(P0 + 9))) { FRESH(); build_tables(F, l); }
        if (EN(9) && IN(P0 + 7)) { FRESH(); ph_scatter(F, l); }
        SEAM(P0 + 7);
        if (EN(10) && IN(P0 + 8)) { FRESH(); ph_gemm1(F, l); }
        SEAM(P0 + 8);
        if (EN(11) && IN(P0 + 9)) { FRESH(); ph_gemm2(F, l); }
        SEAM(P0 + 9);
        if (EN(12) && IN(P0 + 10)) { FRESH(); ph_ln2(F, l); }
        if (l == 0) SEAM(P0 + 10);
    }
#undef IN
#undef SEAM
}

constexpr int N_PHASES = 2 + 22;
extern "C" void kernel_launch(void* const* d_in, const int* in_sizes, int n_in, void* d_out, int out_size, void* d_ws, size_t ws_size, hipStream_t stream) {
    static int grid = 0;
    if (grid == 0) {
        if (n_in != 21 || out_size != NB * SEQ * DM || ws_size < WS_END) { fprintf(stderr, "kernel_launch: unexpected shapes (n_in %d out %d ws %zu)\n", n_in, out_size, ws_size); grid = -1; return; }
        int dev = 0, cus = 0, per_cu = 0;
        if (hipGetDevice(&dev) != hipSuccess || hipDeviceGetAttribute(&cus, hipDeviceAttributeMultiprocessorCount, dev) != hipSuccess) { grid = -1; return; }
        if (hipFuncSetAttribute((const void*)fwd, hipFuncAttributeMaxDynamicSharedMemorySize, LDS_BYTES) != hipSuccess) { fprintf(stderr, "kernel_launch: hipFuncSetAttribute failed\n"); grid = -1; return; }
        if (hipOccupancyMaxActiveBlocksPerMultiprocessor(&per_cu, (const void*)fwd, 512, LDS_BYTES) != hipSuccess || per_cu < 1) { fprintf(stderr, "kernel_launch: occupancy query says %d\n", per_cu); (void)hipGetLastError(); grid = -1; return; }
        grid = cus;
    }
    if (grid < 0) return;
    (void)hipMemsetAsync((char*)d_ws + WS_CTL, 0, CTL_ZERO_BYTES, stream);
    Args a{};
    for (int i = 0; i < 21; ++i) a.in[i] = (const float*)d_in[i];
    a.out = (float*)d_out; a.ws = (unsigned char*)d_ws;
#if MK_ONE_LAUNCH
    a.ph_lo = 0; a.ph_hi = N_PHASES;
    hipLaunchKernelGGL(fwd, dim3(grid), dim3(512), LDS_BYTES, stream, a);
#else
    for (int p = 0; p < N_PHASES; ++p) {
        if (p == 2 + 11 + 2) continue;
        a.ph_lo = p; a.ph_hi = p + 1;
        hipLaunchKernelGGL(fwd, dim3(grid), dim3(512), LDS_BYTES, stream, a);
    }
#endif
    const hipError_t le = hipPeekAtLastError();
    if (le != hipSuccess) fprintf(stderr, "kernel_launch: launch failed: %s\n", hipGetErrorName(le));
}
```

```cpp
#include <hip/hip_runtime.h>
#include <cstdio>
#include <cstdint>

#ifndef MK_ONE_LAUNCH
#define MK_ONE_LAUNCH 1
#endif
#ifndef USE_SIMPLE_GEMM
#define USE_SIMPLE_GEMM 0
#endif

#define GAS __attribute__((address_space(1)))
#define LAS __attribute__((address_space(3)))
typedef unsigned short bf16;
typedef short bf16x8 __attribute__((ext_vector_type(8)));
typedef short s16x4 __attribute__((ext_vector_type(4)));
typedef float f32x4 __attribute__((ext_vector_type(4)));
typedef float f32x16 __attribute__((ext_vector_type(16)));
typedef unsigned u32x4 __attribute__((ext_vector_type(4)));
typedef unsigned u32x2 __attribute__((ext_vector_type(2)));

constexpr int NB = 8, SEQ = 4096, CTXL = 256, DM = 1024, RPB = SEQ + CTXL  , MROWS = NB * RPB  ;
constexpr int NH = 8, NKV = 2, HD = 128, NQKV = (NH + 2 * NKV) * HD  , NWIN = 3 * DM;
constexpr int NE = 256, TOPK = 8, EFF = 256;
constexpr int TL0 = MROWS, TL1 = NB * SEQ;
constexpr float LN_EPS = 1e-5f, QK_EPS = 1e-6f, DN_ALPHA = 1.4142135623730951f, ROUTED_SCALE = 2.5f;
constexpr int P_MAX = MROWS * 9 + 65536;

constexpr size_t MiB = 1u << 20;
constexpr size_t WS_CTL = 0, CTL_ZERO_BYTES = 1 * MiB;
constexpr size_t WS_MOD = 1 * MiB;
constexpr size_t WS_ROPE = 2 * MiB;
constexpr size_t WS_WQKV = 4 * MiB;
constexpr size_t WS_WO = 7 * MiB;
constexpr size_t WS_WIN = 9 * MiB;
constexpr size_t WS_WOUT = 15 * MiB;
constexpr size_t WS_WR = 17 * MiB;
constexpr size_t WS_WGU = 18 * MiB;
constexpr size_t WS_WD = 532 * MiB;
constexpr size_t WS_HX = 789 * MiB;
constexpr size_t WS_QKV = 857 * MiB;
constexpr size_t WS_O = 1061 * MiB;
constexpr size_t WS_Y = 1129 * MiB;
constexpr size_t WS_X1 = 1197 * MiB;
constexpr size_t WS_H2 = 1333 * MiB;
constexpr size_t WS_LOG = 1401 * MiB;
constexpr size_t WS_EIDX = 1435 * MiB;
constexpr size_t WS_GATE = 1437 * MiB;
constexpr size_t WS_POS = 1439 * MiB;
constexpr size_t WS_TOK = 1441 * MiB;
constexpr size_t WS_ACT = 1443 * MiB;
constexpr size_t WS_YS = 1628 * MiB;
constexpr size_t WS_X2 = 2368 * MiB;
constexpr size_t WS_END = 2504 * MiB;
static_assert(WS_ACT + (size_t)P_MAX * 256 * 2 <= WS_YS && WS_YS + (size_t)P_MAX * 1024 * 2 <= WS_X2 && WS_X2 + (size_t)MROWS * 1024 * 4 <= WS_END, "ws map");
static_assert(WS_WGU + (size_t)2 * 257 * 512 * 1024 * 2 <= WS_WD && WS_WD + (size_t)2 * 257 * 1024 * 256 * 2 <= WS_HX, "ws map w");
static_assert(WS_QKV + (size_t)MROWS * 3072 * 2 <= WS_O && WS_X1 + (size_t)MROWS * 1024 * 4 <= WS_H2 && WS_LOG + (size_t)MROWS * 256 * 4 <= WS_EIDX, "ws map a");
constexpr int CW_BAR = 4096;
constexpr int CW_CNT = 16384;
constexpr int CW_FILL = 16384 + 1024;

constexpr int RING_BYTES = 131072;
constexpr int MISC_OFF = RING_BYTES;
constexpr int TBL_OFF = RING_BYTES + 512;
constexpr int TBL_TMP = TBL_OFF + 1088, TBL_EXP = TBL_TMP + 1024;
constexpr int LDS_BYTES = 147456;

__device__ __forceinline__ unsigned cvt_pk_bf16(float lo, float hi) { unsigned r; asm volatile("v_cvt_pk_bf16_f32 %0, %1, %2" : "=v"(r) : "v"(lo), "v"(hi)); return r; }
__device__ __forceinline__ float bf_lo(unsigned w) { return __uint_as_float(w << 16); }
__device__ __forceinline__ float bf_hi(unsigned w) { return __uint_as_float(w & 0xffff0000u); }
__device__ __forceinline__ float wave_sum(float v) {
#pragma unroll
    for (int o = 1; o < 64; o <<= 1) v += __shfl_xor(v, o);
    return v;
}
__device__ __forceinline__ float silu_f(float g) { return g * __builtin_amdgcn_rcpf(1.0f + __builtin_amdgcn_exp2f(-1.4426950408889634f * g)); }

#define XB_TMO      128
#define XB_XCNT(j)  (256  + 64 * (j))
#define XB_XSUB(j)  (1280 + 64 * (j))
#define XB_XGEN(j)  (2304 + 64 * (j))
#define XB_TOP      3328
#define XB_TOPGEN   3392
#define XCD_BAR_WORDS 3456
#define XB_SPIN_CAP (1u << 18)

__device__ __forceinline__ unsigned xb_ld(unsigned* p)              { return __hip_atomic_load(p, __ATOMIC_RELAXED, __HIP_MEMORY_SCOPE_AGENT); }
__device__ __forceinline__ unsigned xb_add(unsigned* p, unsigned v) { return __hip_atomic_fetch_add(p, v, __ATOMIC_RELAXED, __HIP_MEMORY_SCOPE_AGENT); }
__device__ __forceinline__ unsigned xb_xcc_id() { return (unsigned)__builtin_amdgcn_s_getreg((3 << 11) | 20) & 0xFu; }
#define XB_SPIN(cond, bar) do { unsigned _sp = 0; while (cond) { __builtin_amdgcn_s_sleep(1); \
    if ((++_sp & 255u) == 0u) { if (xb_ld(&(bar)[XB_TMO])) break; if (_sp > XB_SPIN_CAP) { atomicAdd(&(bar)[XB_TMO], 1u); break; } } } } while (0)

struct XcdBarrier { unsigned* bar; unsigned x; volatile LAS unsigned* st; };

__device__ __forceinline__ XcdBarrier xcd_barrier_post(unsigned* bar, volatile LAS unsigned* st) {
    XcdBarrier b; b.bar = bar; b.x = xb_xcc_id(); b.st = st;
    if (threadIdx.x == 0) (void)xb_add(&bar[XB_XCNT(b.x)], 1u);
    return b;
}
__device__ __forceinline__ void xcd_barrier_complete(unsigned* bar, unsigned x, unsigned& nloc, unsigned& nx) {
    const unsigned G = gridDim.x * gridDim.y * gridDim.z;
    unsigned sum, cnt, mine, sp = 0u;
    for (;;) {
        sum = 0u; cnt = 0u; mine = 0u;
#pragma unroll
        for (unsigned j = 0; j < 16; ++j) { const unsigned c = xb_ld(&bar[XB_XCNT(j)]); sum += c; cnt += (c > 0u) ? 1u : 0u; mine = (j == x) ? c : mine; }
        if (sum == G) break;
        __builtin_amdgcn_s_sleep(1);
        if ((++sp & 255u) == 0u) { if (xb_ld(&bar[XB_TMO])) break; if (sp > XB_SPIN_CAP) { atomicAdd(&bar[XB_TMO], 1u); break; } }
    }
    nloc = mine > 0u ? mine : 1u; nx = cnt > 0u ? cnt : 1u;
}
__device__ __forceinline__ void xcd_barrier(const XcdBarrier& b) {
    asm volatile("s_waitcnt vmcnt(0)" ::: "memory");
    __syncthreads();
    if (threadIdx.x == 0) {
        unsigned* bar = b.bar;
        __builtin_amdgcn_s_waitcnt(0);
        unsigned nloc = b.st[0], nx = b.st[1];
        if (nloc == 0u) { xcd_barrier_complete(bar, b.x, nloc, nx); b.st[0] = nloc; b.st[1] = nx; }
        const unsigned old = xb_add(&bar[XB_XSUB(b.x)], 1u);
        const unsigned gen = old / nloc;
        if (old + 1u == (gen + 1u) * nloc) {
            __builtin_amdgcn_fence(__ATOMIC_RELEASE, "agent");
            asm volatile("s_waitcnt vmcnt(0)" ::: "memory");
            const unsigned og = xb_add(&bar[XB_TOP], 1u);
            const unsigned tg = og / nx;
            if (og + 1u == (tg + 1u) * nx) xb_add(&bar[XB_TOPGEN], 1u);
            else XB_SPIN(xb_ld(&bar[XB_TOPGEN]) == tg, bar);
            __builtin_amdgcn_fence(__ATOMIC_ACQUIRE, "agent");
            xb_add(&bar[XB_XGEN(b.x)], 1u);
            asm volatile("s_waitcnt vmcnt(0)" ::: "memory");
        } else {
            XB_SPIN(xb_ld(&bar[XB_XGEN(b.x)]) == gen, bar);
            __builtin_amdgcn_fence(__ATOMIC_ACQUIRE, "agent");
            asm volatile("s_waitcnt vmcnt(0)" ::: "memory");
        }
    }
    __syncthreads();
}

namespace pg8 {
constexpr int BM = 256, BK = 64, HALF = 128, HTB = HALF * BK * 2, STAGE_BYTES = 8 * HTB;
__host__ __device__ __forceinline__ int lds_byte(int r, int c) { const int st = (r >> 4) * 2 + (c >> 5), rr = r & 15, cc = c & 31, ob = rr * 64 + cc * 2; return st * 1024 + (ob ^ (((ob >> 9) & 1) << 5)); }
__host__ __device__ __forceinline__ void stage_rc(int b, int& R, int& C) { const int st = b / 1024, sb = b % 1024, swz = sb ^ (((sb >> 9) & 1) << 5); R = (st >> 1) * 16 + swz / 64; C = (st & 1) * 32 + (swz % 64) / 2; }
__host__ __device__ __forceinline__ int perm32(int rho) { const int n = rho >> 4, i = rho & 15; return 8 * (i >> 2) + 4 * n + (i & 3); }

struct Unit { int rt, pn, ex; };

struct EpiBf16 {
    bf16* O; int ldc;
    __device__ __forceinline__ void operator()(const f32x4 (&acc)[2][2][4][2], const Unit& u, int wr, int wc, int fr, int fq) const {
        const int row0 = u.rt * BM + wr * 64 + fr, col0 = u.pn * BM + wc * 32 + 8 * fq;
#pragma unroll
        for (int ai = 0; ai < 2; ++ai)
#pragma unroll
            for (int m = 0; m < 4; ++m) { bf16* rowp = O + (size_t)(row0 + ai * HALF + m * 16) * ldc + col0;
#pragma unroll
                for (int bj = 0; bj < 2; ++bj) { const f32x4 v0 = acc[ai][bj][m][0], v1 = acc[ai][bj][m][1];
                    u32x4 w; w.x = cvt_pk_bf16(v0[0], v0[1]); w.y = cvt_pk_bf16(v0[2], v0[3]); w.z = cvt_pk_bf16(v1[0], v1[1]); w.w = cvt_pk_bf16(v1[2], v1[3]);
                    *(u32x4*)(rowp + bj * HALF) = w; } }
    }
};
struct EpiF32 {
    float* C; int ldc;
    __device__ __forceinline__ void operator()(const f32x4 (&acc)[2][2][4][2], const Unit& u, int wr, int wc, int fr, int fq) const {
        const int row0 = u.rt * BM + wr * 64 + fr, col0 = u.pn * BM + wc * 32 + 8 * fq;
#pragma unroll
        for (int ai = 0; ai < 2; ++ai)
#pragma unroll
            for (int m = 0; m < 4; ++m) { float* rowp = C + (size_t)(row0 + ai * HALF + m * 16) * ldc + col0;
#pragma unroll
                for (int bj = 0; bj < 2; ++bj) { *(f32x4*)(rowp + bj * HALF) = acc[ai][bj][m][0]; *(f32x4*)(rowp + bj * HALF + 4) = acc[ai][bj][m][1]; } }
    }
};
struct EpiSwiGLU {
    bf16* O;
    __device__ __forceinline__ void operator()(const f32x4 (&acc)[2][2][4][2], const Unit& u, int wr, int wc, int fr, int fq) const {
        const int row0 = u.rt * BM + wr * 64 + fr, col0 = u.pn * HALF + wc * 32 + 8 * fq;
#pragma unroll
        for (int ai = 0; ai < 2; ++ai)
#pragma unroll
            for (int m = 0; m < 4; ++m) { bf16* rowp = O + (size_t)(row0 + ai * HALF + m * 16) * EFF + col0;
                float r[8];
#pragma unroll
                for (int n = 0; n < 2; ++n)
#pragma unroll
                    for (int j = 0; j < 4; ++j) r[n * 4 + j] = silu_f(acc[ai][0][m][n][j]) * acc[ai][1][m][n][j];
                u32x4 w; w.x = cvt_pk_bf16(r[0], r[1]); w.y = cvt_pk_bf16(r[2], r[3]); w.z = cvt_pk_bf16(r[4], r[5]); w.w = cvt_pk_bf16(r[6], r[7]);
                *(u32x4*)rowp = w; }
    }
};

struct DenseOrder {
    int nM, nN, nwg, G, c, latent; const char* A; const char* Bt; size_t tstep;
    __device__ void init(int nM_, int nN_, int G_, int c_, int latent_, const void* A_, const void* Bt_, int K) { nM = nM_; nN = nN_; nwg = nM * nN; G = G_; c = c_; latent = latent_; A = (const char*)A_; Bt = (const char*)Bt_; tstep = (size_t)BM * K * 2; }
    __device__ __forceinline__ bool next(int i, Unit& u) const {
        const long L = (long)i * G + c; if (L >= nwg) return false;
        int wgid = (int)L; { const int q = nwg / 8, r = nwg % 8, xcd = wgid % 8, off = wgid / 8; wgid = (xcd < r ? xcd * (q + 1) : r * (q + 1) + (xcd - r) * q) + off; }
        const int nig = 8 * nN, gid = wgid / nig, fm = gid * 8, gsz = (nM - fm) < 8 ? (nM - fm) : 8;
        const int pm = fm + ((wgid % nig) % gsz); u.pn = (wgid % nig) / gsz; u.ex = 0;
        u.rt = latent ? (pm >> 4) * 17 + 1 + (pm & 15) : pm; return true;
    }
    __device__ __forceinline__ const char* a_base(const Unit& u) const { return A + (size_t)u.rt * tstep; }
    __device__ __forceinline__ const char* b_base(const Unit& u) const { return Bt + (size_t)u.pn * tstep; }
    __device__ __forceinline__ const int* tok(const Unit&) const { return nullptr; }
};
template <int NTN_LOG2>
struct ExpertOrder {
    int nunits, G, c; const LAS unsigned short* texp; const char* A; const char* Bt; const int* toks; unsigned a_tstep, b_tstep;
    __device__ __forceinline__ bool next(int i, Unit& u) const {
        const int L = i * G + c; if (L >= nunits) return false;
        const int tile = L >> NTN_LOG2; u.pn = L & ((1 << NTN_LOG2) - 1); u.rt = tile; u.ex = (int)texp[tile]; return true;
    }
    __device__ __forceinline__ const char* a_base(const Unit& u) const { return A + (size_t)u.rt * a_tstep; }
    __device__ __forceinline__ const char* b_base(const Unit& u) const { return Bt + (size_t)((u.ex << NTN_LOG2) + u.pn) * b_tstep; }
    __device__ __forceinline__ const int* tok(const Unit& u) const { return toks + (size_t)u.rt * BM; }
};

#if !USE_SIMPLE_GEMM
template <class Epi, class Sched, bool GATHER>
__device__ __forceinline__ void gemm_phase(LAS unsigned char* lds, const Sched& S, const Epi& E, const int K, const int tid) {
    const int wid = __builtin_amdgcn_readfirstlane(tid >> 6), lane = tid & 63, wr = wid >> 2, wc = wid & 3, fr = lane & 15, fq = lane >> 4;
    const int nt = K / BK;
    int Rr[2], Cc[2];
    unsigned voffB[2];
#pragma unroll
    for (int i = 0; i < 2; ++i) { int R, C; stage_rc(tid * 16 + i * 8192, R, C); const int Rb = (R & ~31) + perm32(R & 31); Rr[i] = R; Cc[i] = C; voffB[i] = (unsigned)(Rb * K + C) * 2u; }
    const size_t kstep = (size_t)(BK * 2);
    const size_t hstep = (size_t)HALF * K * 2;
    const unsigned ldsw = (unsigned)wid * 1024u;
    const int aoff = lds_byte(wr * 64 + fr, fq * 8), boff = lds_byte(wc * 32 + fr, fq * 8);
#define PG8_SA(b, h) (((b) * 2 + (h)) * HTB)
#define PG8_SB(b, h) ((4 + (b) * 2 + (h)) * HTB)
#define PG8_STAGE2(bufoff, gbase, v0, v1) do { \
        __builtin_amdgcn_global_load_lds((const unsigned*)((const char*)(gbase) + (v0)), (LAS unsigned*)(lds + (bufoff) + ldsw), 16, 0, 0); \
        __builtin_amdgcn_global_load_lds((const unsigned*)((const char*)(gbase) + (v1)), (LAS unsigned*)(lds + (bufoff) + ldsw + 8192), 16, 0, 0); } while (0)
#define PG8_STAGEB(bufoff, gbase) PG8_STAGE2(bufoff, gbase, voffB[0], voffB[1])
#define PG8_LDA(dst, b, h) do { _Pragma("unroll") for (int m = 0; m < 4; ++m) _Pragma("unroll") for (int k = 0; k < 2; ++k) dst[m][k] = *(const LAS bf16x8*)(lds + PG8_SA(b, h) + aoff + m * 2048 + k * 1024); } while (0)
#define PG8_LDB(dst, b, h) do { _Pragma("unroll") for (int n = 0; n < 2; ++n) _Pragma("unroll") for (int k = 0; k < 2; ++k) dst[n][k] = *(const LAS bf16x8*)(lds + PG8_SB(b, h) + boff + n * 2048 + k * 1024); } while (0)
#define PG8_MMA(ai, bj, At, Bt) do { __builtin_amdgcn_s_setprio(1); _Pragma("unroll") for (int m = 0; m < 4; ++m) _Pragma("unroll") for (int n = 0; n < 2; ++n) _Pragma("unroll") for (int k = 0; k < 2; ++k) \
        acc[ai][bj][m][n] = __builtin_amdgcn_mfma_f32_16x16x32_bf16(Bt[n][k], At[m][k], acc[ai][bj][m][n], 0, 0, 0); __builtin_amdgcn_s_setprio(0); } while (0)
#define PG8_WAIT_V(n) asm volatile("s_waitcnt vmcnt(" #n ")" ::: "memory")
#define PG8_WAIT_L(n) asm volatile("s_waitcnt lgkmcnt(" #n ")" ::: "memory")
#define PG8_BAR __builtin_amdgcn_s_barrier()
#define PG8_SCHED __builtin_amdgcn_sched_barrier(0)
    Unit cur, nxt; int ui = 0;
    if (!S.next(0, cur)) return;
    f32x4 acc[2][2][4][2];
#pragma unroll
    for (int a = 0; a < 2; ++a)
#pragma unroll
        for (int b = 0; b < 2; ++b)
#pragma unroll
            for (int m = 0; m < 4; ++m)
#pragma unroll
                for (int n = 0; n < 2; ++n) acc[a][b][m][n] = (f32x4){0.f, 0.f, 0.f, 0.f};
    bf16x8 At[4][2], B0[2][2], B1[2][2];
    unsigned c00, c01, c10, c11, n00, n01, n10, n11;
    if constexpr (GATHER) { const int* tk = S.tok(cur);
        c00 = (unsigned)(tk[Rr[0]] * K + Cc[0]) * 2u; c01 = (unsigned)(tk[Rr[1]] * K + Cc[1]) * 2u; c10 = (unsigned)(tk[HALF + Rr[0]] * K + Cc[0]) * 2u; c11 = (unsigned)(tk[HALF + Rr[1]] * K + Cc[1]) * 2u;
    } else { c00 = (unsigned)(Rr[0] * K + Cc[0]) * 2u; c01 = (unsigned)(Rr[1] * K + Cc[1]) * 2u; c10 = c00 + (unsigned)hstep; c11 = c01 + (unsigned)hstep; }
    n00 = c00; n01 = c01; n10 = c10; n11 = c11;
    const char* cA = S.a_base(cur); const char* cB = S.b_base(cur);
    PG8_STAGEB(PG8_SB(0, 0), cB); PG8_STAGEB(PG8_SB(0, 1), cB + hstep); PG8_STAGE2(PG8_SA(0, 0), cA, c00, c01); PG8_STAGE2(PG8_SA(0, 1), cA, c10, c11);
    if (wr == 1) PG8_BAR;
    PG8_WAIT_V(2); PG8_BAR;
    PG8_STAGEB(PG8_SB(1, 0), cB + kstep); PG8_STAGE2(PG8_SA(1, 0), cA + kstep, c00, c01); PG8_STAGEB(PG8_SB(1, 1), cB + hstep + kstep);
    PG8_WAIT_V(6); PG8_BAR;
    for (;;) {
        const bool has_next = S.next(ui + 1, nxt);
        const char* nA = has_next ? S.a_base(nxt) : cA; const char* nB = has_next ? S.b_base(nxt) : cB;
        if constexpr (GATHER) { if (has_next) { const int* tk = S.tok(nxt);
            n00 = (unsigned)(tk[Rr[0]] * K + Cc[0]) * 2u; n01 = (unsigned)(tk[Rr[1]] * K + Cc[1]) * 2u; n10 = (unsigned)(tk[HALF + Rr[0]] * K + Cc[0]) * 2u; n11 = (unsigned)(tk[HALF + Rr[1]] * K + Cc[1]) * 2u; }
            else { n00 = c00; n01 = c01; n10 = c10; n11 = c11; } }
#pragma nounroll
        for (int t = 0; t < nt; t += 2) {
            const bool last = (t == nt - 2);
            const char* a1 = cA + (size_t)(t + 1) * kstep;
            const char* a2 = last ? nA : cA + (size_t)(t + 2) * kstep; const char* b2 = last ? nB : cB + (size_t)(t + 2) * kstep;
            const char* a3 = a2 + kstep; const char* b3 = b2 + kstep;
            const unsigned s00 = last ? n00 : c00, s01 = last ? n01 : c01, s10 = last ? n10 : c10, s11 = last ? n11 : c11;
            PG8_LDB(B0, 0, 0); PG8_LDB(B1, 0, 1); PG8_SCHED; PG8_LDA(At, 0, 0); PG8_STAGE2(PG8_SA(1, 1), a1, c10, c11);
            PG8_WAIT_V(8); PG8_WAIT_L(0); PG8_BAR; PG8_MMA(0, 0, At, B0); PG8_MMA(0, 1, At, B1); PG8_BAR; PG8_SCHED;
            PG8_LDA(At, 0, 1); PG8_STAGEB(PG8_SB(0, 0), b2); PG8_STAGEB(PG8_SB(0, 1), b2 + hstep); PG8_STAGE2(PG8_SA(0, 0), a2, s00, s01);
            PG8_WAIT_V(8); PG8_WAIT_L(0); PG8_BAR; PG8_MMA(1, 0, At, B0); PG8_MMA(1, 1, At, B1); PG8_BAR; PG8_SCHED;
            PG8_LDB(B0, 1, 0); PG8_LDB(B1, 1, 1); PG8_SCHED; PG8_LDA(At, 1, 0); PG8_STAGE2(PG8_SA(0, 1), a2, s10, s11);
            PG8_WAIT_V(8); PG8_WAIT_L(0); PG8_BAR; PG8_MMA(0, 0, At, B0); PG8_MMA(0, 1, At, B1); PG8_BAR; PG8_SCHED;
            PG8_LDA(At, 1, 1); PG8_STAGEB(PG8_SB(1, 0), b3); PG8_STAGEB(PG8_SB(1, 1), b3 + hstep); PG8_STAGE2(PG8_SA(1, 0), a3, s00, s01);
            PG8_WAIT_V(8); PG8_WAIT_L(0); PG8_BAR; PG8_MMA(1, 0, At, B0); PG8_MMA(1, 1, At, B1); PG8_BAR; PG8_SCHED;
        }
        if (wr == 0) PG8_BAR;
        E(acc, cur, wr, wc, fr, fq);
        if (!has_next) break;
#pragma unroll
        for (int a = 0; a < 2; ++a)
#pragma unroll
            for (int b = 0; b < 2; ++b)
#pragma unroll
                for (int m = 0; m < 4; ++m)
#pragma unroll
                    for (int n = 0; n < 2; ++n) acc[a][b][m][n] = (f32x4){0.f, 0.f, 0.f, 0.f};
        cur = nxt; cA = nA; cB = nB; ++ui; c00 = n00; c01 = n01; c10 = n10; c11 = n11;
        if (wr == 1) PG8_BAR;
    }
    PG8_WAIT_V(0);
    PG8_BAR;
#undef PG8_SA
#undef PG8_SB
#undef PG8_STAGE2
#undef PG8_STAGEB
#undef PG8_LDA
#undef PG8_LDB
#undef PG8_MMA
#undef PG8_WAIT_V
#undef PG8_WAIT_L
#undef PG8_BAR
#undef PG8_SCHED
}
#else
template <class Epi, class Sched, bool GATHER>
__device__ __forceinline__ void gemm_phase(LAS unsigned char*, const Sched& S, const Epi& E, const int K, const int tid) {
    const int wid = __builtin_amdgcn_readfirstlane(tid >> 6), lane = tid & 63, wr = wid >> 2, wc = wid & 3, fr = lane & 15, fq = lane >> 4;
    for (int ui = 0;; ++ui) {
        Unit u; if (!S.next(ui, u)) break;
        f32x4 acc[2][2][4][2];
#pragma unroll
        for (int a = 0; a < 2; ++a)
#pragma unroll
            for (int b = 0; b < 2; ++b)
#pragma unroll
                for (int m = 0; m < 4; ++m)
#pragma unroll
                    for (int n = 0; n < 2; ++n) acc[a][b][m][n] = (f32x4){0.f, 0.f, 0.f, 0.f};
        const char* Ab = S.a_base(u); const char* Bb = S.b_base(u);
        unsigned ao[2][4], bo[2][2];
#pragma unroll
        for (int ai = 0; ai < 2; ++ai)
#pragma unroll
            for (int m = 0; m < 4; ++m) { const int r = ai * HALF + wr * 64 + m * 16 + fr; int rr = r; if constexpr (GATHER) rr = S.tok(u)[r]; ao[ai][m] = (unsigned)(rr * K + fq * 8) * 2u; }
#pragma unroll
        for (int bj = 0; bj < 2; ++bj)
#pragma unroll
            for (int n = 0; n < 2; ++n) { const int r = bj * HALF + wc * 32 + 8 * (fr >> 2) + 4 * n + (fr & 3); bo[bj][n] = (unsigned)(r * K + fq * 8) * 2u; }
        for (int k0 = 0; k0 < K; k0 += 32) {
            bf16x8 Af[2][4], Bf[2][2];
#pragma unroll
            for (int ai = 0; ai < 2; ++ai)
#pragma unroll
                for (int m = 0; m < 4; ++m) Af[ai][m] = *(const bf16x8*)(Ab + ao[ai][m] + k0 * 2);
#pragma unroll
            for (int bj = 0; bj < 2; ++bj)
#pragma unroll
                for (int n = 0; n < 2; ++n) Bf[bj][n] = *(const bf16x8*)(Bb + bo[bj][n] + k0 * 2);
#pragma unroll
            for (int ai = 0; ai < 2; ++ai)
#pragma unroll
                for (int bj = 0; bj < 2; ++bj)
#pragma unroll
                    for (int m = 0; m < 4; ++m)
#pragma unroll
                        for (int n = 0; n < 2; ++n) acc[ai][bj][m][n] = __builtin_amdgcn_mfma_f32_16x16x32_bf16(Bf[bj][n], Af[ai][m], acc[ai][bj][m][n], 0, 0, 0);
        }
        E(acc, u, wr, wc, fr, fq);
    }
}
#endif
}

namespace att {
constexpr int D = 128, NW = 8, QBLK = 32, KVBLK = 64;
constexpr float SCALE = 0.088388347648318440f, THR = 8.f;
#ifndef ATT_SDEPTH
#define ATT_SDEPTH 1
#endif
constexpr int SDEPTH = ATT_SDEPTH;
constexpr int LDQ = NQKV, LDK = NQKV, LDO = DM;
constexpr size_t SHM_V = KVBLK * D * 2, SHM_K = KVBLK * D * 2, SHM_ATTN = 2 * SHM_V + 2 * SHM_K + NW * 64 * 4;
#define KSWZ(row, colB) ((row) * 256 + ((colB) ^ (((row) & 7) << 4)))
#define SBAR() __builtin_amdgcn_sched_barrier(0)
__device__ __forceinline__ int crow(int r, int hi) { return (r & 3) + 8 * (r >> 2) + 4 * hi; }
__device__ __forceinline__ unsigned cvtpk(float lo, float hi) { unsigned r; asm volatile("v_cvt_pk_bf16_f32 %0, %1, %2" : "=v"(r) : "v"(lo), "v"(hi)); return r; }
__device__ __forceinline__ bf16x8 ld8(const bf16* p) { return *reinterpret_cast<const bf16x8*>(p); }

__device__ __forceinline__ void partialSM(f32x16& p0, f32x16& p1, float& m_reg, float& mn, float& alpha) {
  constexpr float C = SCALE * 1.4426950408889634f;
  float pmax = p0[0]; for (int r = 1; r < 16; ++r) pmax = fmaxf(pmax, p0[r]); for (int r = 0; r < 16; ++r) pmax = fmaxf(pmax, p1[r]);
  { auto rr = __builtin_amdgcn_permlane32_swap(__float_as_uint(pmax), __float_as_uint(pmax), false, false);
    pmax = fmaxf(__uint_as_float(rr[0]), __uint_as_float(rr[1])); }
  if (__builtin_expect(__all(pmax - m_reg <= THR / SCALE), 1)) { mn = m_reg; alpha = 1.f; }
  else { mn = fmaxf(m_reg, pmax); alpha = __builtin_amdgcn_exp2f((m_reg - mn) * C); m_reg = mn; }
  float mnC = -mn * C;
  for (int r = 0; r < 16; ++r) p0[r] = fmaf(p0[r], C, mnC); for (int r = 0; r < 16; ++r) p1[r] = fmaf(p1[r], C, mnC);
  for (int r = 0; r < 16; ++r) p0[r] = __builtin_amdgcn_exp2f(p0[r]);
}
__device__ __forceinline__ void finishSM(f32x16& p0, f32x16& p1, float alpha, float& l_reg, bf16x8& pa0, bf16x8& pa1, bf16x8& pa2, bf16x8& pa3) {
  for (int r = 0; r < 16; ++r) p1[r] = __builtin_amdgcn_exp2f(p1[r]);
  float ps = 0; for (int r = 0; r < 16; ++r) ps += p0[r]; for (int r = 0; r < 16; ++r) ps += p1[r];
  { auto rr = __builtin_amdgcn_permlane32_swap(__float_as_uint(ps), __float_as_uint(ps), false, false);
    ps = __uint_as_float(rr[0]) + __uint_as_float(rr[1]); }
  l_reg = l_reg * alpha + ps;
#define PK4(P, BASE, OUT) do { unsigned a0 = cvtpk(P[BASE + 0], P[BASE + 1]), a1 = cvtpk(P[BASE + 2], P[BASE + 3]);   \
    unsigned b0 = cvtpk(P[BASE + 4], P[BASE + 5]), b1 = cvtpk(P[BASE + 6], P[BASE + 7]);                              \
    auto r0 = __builtin_amdgcn_permlane32_swap(a0, b0, false, false); auto r1 = __builtin_amdgcn_permlane32_swap(a1, b1, false, false); \
    u32x4 w = {r0[0], r1[0], r0[1], r1[1]}; OUT = *reinterpret_cast<bf16x8*>(&w); } while (0)
  PK4(p0, 0, pa0); PK4(p0, 8, pa1); PK4(p1, 0, pa2); PK4(p1, 8, pa3);
#undef PK4
}
__device__ __forceinline__ void qkt(f32x16& p0, f32x16& p1, const bf16* Ks, const bf16x8* qr, int r32, int hi) {
  p0 = f32x16{}; p1 = f32x16{};
  for (int d0 = 0; d0 < 8; ++d0) { int cb = (d0 * 16 + hi * 8) * 2;
    bf16x8 b0 = *reinterpret_cast<const bf16x8*>((const char*)Ks + KSWZ(r32, cb));
    bf16x8 b1 = *reinterpret_cast<const bf16x8*>((const char*)Ks + KSWZ(32 + r32, cb));
    p0 = __builtin_amdgcn_mfma_f32_32x32x16_bf16(b0, qr[d0], p0, 0, 0, 0);
    p1 = __builtin_amdgcn_mfma_f32_32x32x16_bf16(b1, qr[d0], p1, 0, 0, 0); }
}
__device__ __forceinline__ int v_st(int k, int c) { const int kk = (k & ~0xC) | ((k & 4) << 1) | ((k & 8) >> 1); return ((kk >> 3) * 4 + (c >> 5)) * 512 + ((kk & 7) * 32 + (c & 31)) * 2; }
__device__ __forceinline__ int v_rd_base(int lane) { return ((lane & 3) << 3) | (((lane >> 2) & 3) << 6) | (((lane >> 4) & 1) << 5) | (((lane >> 5) & 1) << 8); }
constexpr int v_rd_off(int d0, int ks, int half) { return d0 * 512 + ks * 4096 + half * 2048; }
template <int OFF> __device__ __forceinline__ s16x4 tr_read(int vb) {
  s16x4 r; asm volatile("ds_read_b64_tr_b16 %0, %1 offset:%2" : "=&v"(r) : "v"(vb), "i"(OFF) : "memory"); return r;
}
template <int D0> __device__ __forceinline__ void pv_one(f32x16& od, int vb, bf16x8 pa0, bf16x8 pa1, bf16x8 pa2, bf16x8 pa3) {
  const s16x4 l0 = tr_read<v_rd_off(D0, 0, 0)>(vb), h0 = tr_read<v_rd_off(D0, 0, 1)>(vb), l1 = tr_read<v_rd_off(D0, 1, 0)>(vb), h1 = tr_read<v_rd_off(D0, 1, 1)>(vb);
  const s16x4 l2 = tr_read<v_rd_off(D0, 2, 0)>(vb), h2 = tr_read<v_rd_off(D0, 2, 1)>(vb), l3 = tr_read<v_rd_off(D0, 3, 0)>(vb), h3 = tr_read<v_rd_off(D0, 3, 1)>(vb);
  asm volatile("s_waitcnt lgkmcnt(0)" ::: "memory"); SBAR();
#define PK(L, H) (bf16x8){L[0], L[1], L[2], L[3], H[0], H[1], H[2], H[3]}
  od = __builtin_amdgcn_mfma_f32_32x32x16_bf16(pa0, PK(l0, h0), od, 0, 0, 0);
  od = __builtin_amdgcn_mfma_f32_32x32x16_bf16(pa1, PK(l1, h1), od, 0, 0, 0);
  od = __builtin_amdgcn_mfma_f32_32x32x16_bf16(pa2, PK(l2, h2), od, 0, 0, 0);
  od = __builtin_amdgcn_mfma_f32_32x32x16_bf16(pa3, PK(l3, h3), od, 0, 0, 0);
#undef PK
}
__device__ __forceinline__ void pv_d0(f32x16* o, int vb, bf16x8 pa0, bf16x8 pa1, bf16x8 pa2, bf16x8 pa3) {
  pv_one<0>(o[0], vb, pa0, pa1, pa2, pa3); pv_one<1>(o[1], vb, pa0, pa1, pa2, pa3); pv_one<2>(o[2], vb, pa0, pa1, pa2, pa3); pv_one<3>(o[3], vb, pa0, pa1, pa2, pa3);
}

__device__ __forceinline__ void attn_dense_body(const bf16* __restrict__ Qb, const bf16* __restrict__ Kh, const bf16* __restrict__ Vh, bf16* __restrict__ Ob, int seq, char* lds, const int tid) {
  const int wid = tid >> 6, lane = tid & 63, r32 = lane & 31, hi = lane >> 5;
  bf16* V_lds = (bf16*)lds; bf16* K_lds = (bf16*)(lds + 2 * SHM_V);
  float* ws = (float*)(lds + 2 * SHM_V + 2 * SHM_K) + wid * 64; float* li_l = ws; float* al_l = ws + 32;
  float m_reg = -1e30f, l_reg = 0; f32x16 o[4] = {}; bf16x8 qr[8];
  const bf16* Qw = Qb + (long)(wid * QBLK + r32) * LDQ + hi * 8;
#pragma unroll
  for (int d0 = 0; d0 < 8; ++d0) qr[d0] = ld8(Qw + d0 * 16);
  const int sr = tid >> 4, sc = (tid & 15) * 8, vst0 = v_st(sr, sc), vst1 = v_st(32 + sr, sc);
  const int vb0 = (int)(uintptr_t)V_lds + v_rd_base(lane);
  struct { bf16x8 vs0, vs1, ks0, ks1; } sr_[SDEPTH];
#define SLOAD(i, k0) do { sr_[i].vs0 = ld8(&Vh[(long)((k0) + sr) * LDK + sc]); sr_[i].vs1 = ld8(&Vh[(long)((k0) + 32 + sr) * LDK + sc]); \
    sr_[i].ks0 = ld8(&Kh[(long)((k0) + sr) * LDK + sc]); sr_[i].ks1 = ld8(&Kh[(long)((k0) + 32 + sr) * LDK + sc]); } while (0)
#define SWRITE(b, i) do { *(bf16x8*)((char*)V_lds + (b) * SHM_V + vst0) = sr_[i].vs0;          \
    *(bf16x8*)((char*)V_lds + (b) * SHM_V + vst1) = sr_[i].vs1; int kc = sc * 2;               \
    *(bf16x8*)((char*)K_lds + (b) * SHM_K + KSWZ(sr, kc)) = sr_[i].ks0;                       \
    *(bf16x8*)((char*)K_lds + (b) * SHM_K + KSWZ(32 + sr, kc)) = sr_[i].ks1; } while (0)
#define SWAIT() do { if constexpr (SDEPTH == 2) asm volatile("s_waitcnt vmcnt(4)" ::: "memory"); else asm volatile("s_waitcnt vmcnt(0)" ::: "memory"); } while (0)
#define RESC(a) do { if (__any((a) < 1.f)) { if (hi == 0) al_l[r32] = (a); asm volatile("s_waitcnt lgkmcnt(0)" ::: "memory"); \
    for (int d = 0; d < 4; ++d) for (int r = 0; r < 16; ++r) o[d][r] *= al_l[crow(r, hi)]; } } while (0)
  f32x16 pA0, pA1, pB0, pB1; float mnA, mnB, alA, alB; bf16x8 pa0, pa1, pa2, pa3; const int NT = seq / KVBLK;
  constexpr int SE = 0, SO = SDEPTH - 1;
  SLOAD(SE, 0); asm volatile("s_waitcnt vmcnt(0)" ::: "memory"); SWRITE(0, SE); __syncthreads();
  qkt(pA0, pA1, K_lds, qr, r32, hi); partialSM(pA0, pA1, m_reg, mnA, alA);
  SLOAD(SO, KVBLK); if constexpr (SDEPTH == 2) { if (2 < NT) SLOAD(SE, 2 * KVBLK); }
  SWAIT(); SWRITE(1, SO); __syncthreads();
  for (int j = 1; j + 1 < NT; j += 2) {
    SBAR(); qkt(pB0, pB1, (bf16*)((char*)K_lds + SHM_K), qr, r32, hi);
    finishSM(pA0, pA1, alA, l_reg, pa0, pa1, pa2, pa3); SBAR();
    SLOAD(SO, (j + SDEPTH) * KVBLK); SBAR();
    pv_d0(o, vb0, pa0, pa1, pa2, pa3); partialSM(pB0, pB1, m_reg, mnB, alB);
    __syncthreads(); SWAIT(); SWRITE(0, SE);
    RESC(alB); __syncthreads();
    SBAR(); qkt(pA0, pA1, K_lds, qr, r32, hi);
    finishSM(pB0, pB1, alB, l_reg, pa0, pa1, pa2, pa3); SBAR();
    if (SDEPTH == 1 || j + 3 < NT) SLOAD(SE, (j + 1 + SDEPTH) * KVBLK); SBAR();
    pv_d0(o, vb0 + (int)SHM_V, pa0, pa1, pa2, pa3); partialSM(pA0, pA1, m_reg, mnA, alA);
    __syncthreads(); SWAIT(); SWRITE(1, SO);
    RESC(alA); __syncthreads();
  }
  SBAR(); qkt(pB0, pB1, (bf16*)((char*)K_lds + SHM_K), qr, r32, hi);
  finishSM(pA0, pA1, alA, l_reg, pa0, pa1, pa2, pa3); SBAR();
  pv_d0(o, vb0, pa0, pa1, pa2, pa3); partialSM(pB0, pB1, m_reg, mnB, alB);
  __syncthreads(); RESC(alB);
  finishSM(pB0, pB1, alB, l_reg, pa0, pa1, pa2, pa3); SBAR();
  pv_d0(o, vb0 + (int)SHM_V, pa0, pa1, pa2, pa3);
  if (hi == 0) li_l[r32] = l_reg; asm volatile("s_waitcnt lgkmcnt(0)" ::: "memory");
  float rli[16];
#pragma unroll
  for (int r = 0; r < 16; ++r) rli[r] = __builtin_amdgcn_rcpf(li_l[crow(r, hi)]);
  bf16* Ow = Ob + (long)(wid * QBLK) * LDO;
#pragma unroll
  for (int r = 0; r < 16; r += 2) {
#pragma unroll
    for (int d0 = 0; d0 < 4; ++d0) {
      const float a = o[d0][r] * rli[r], b = o[d0][r + 1] * rli[r + 1];
      const float send = (lane & 1) ? a : b; const float recv = __shfl_xor(send, 1);
      const unsigned w = (lane & 1) ? cvtpk(recv, b) : cvtpk(a, recv);
      const int orow = crow(r, hi) + (lane & 1), ocol = d0 * 32 + (r32 & ~1);
      *(unsigned*)(Ow + (long)orow * LDO + ocol) = w; } }
#undef SLOAD
#undef SWRITE
#undef SWAIT
#undef RESC
}
}

struct Args { const float* in[21]; float* out; unsigned char* ws; int ph_lo, ph_hi; };
static_assert(sizeof(Args) == 23 * 8 + 8, "Args has no padding");
template <int OFF> __device__ __forceinline__ unsigned long long karg64() {
    unsigned long long v; const unsigned long long kp = (unsigned long long)__builtin_amdgcn_kernarg_segment_ptr();
    asm volatile("s_load_dwordx2 %0, %1, %2\n\ts_waitcnt lgkmcnt(0)" : "=s"(v) : "s"(kp), "i"(OFF) : "memory"); return v;
}
#define KIN(i) ((const float*)(const GAS float*)karg64<8 * (i)>())
#define KOUT() ((float*)(GAS float*)karg64<168>())
#define KWS() ((unsigned char*)(GAS unsigned char*)karg64<176>())

struct Ctx { int tid, lane, wave, G, vcu, gw, NGW; LAS unsigned char* lds; };

__device__ __forceinline__ void transpose_item(const float* W, int K, int N, bf16* WT, int k0, int n0, int drow0, LAS float* scr, int lane) {
#pragma unroll 8
    for (int i = 0; i < 32; ++i) { const int kk = 2 * i + (lane >> 5); scr[kk * 33 + (lane & 31)] = W[(size_t)(k0 + kk) * N + n0 + (lane & 31)]; }
    asm volatile("s_waitcnt lgkmcnt(0)" ::: "memory");
    const int c = lane & 7;
#pragma unroll
    for (int j = 0; j < 4; ++j) { const int n = (lane >> 3) + 8 * j; const LAS float* s = scr + (8 * c) * 33 + n;
        u32x4 o; o.x = cvt_pk_bf16(s[0 * 33], s[1 * 33]); o.y = cvt_pk_bf16(s[2 * 33], s[3 * 33]); o.z = cvt_pk_bf16(s[4 * 33], s[5 * 33]); o.w = cvt_pk_bf16(s[6 * 33], s[7 * 33]);
        *(u32x4*)(WT + (size_t)(drow0 + n) * K + k0 + 8 * c) = o; }
    asm volatile("s_waitcnt lgkmcnt(0)" ::: "memory");
}
__device__ __forceinline__ int gu_row(int n0) { return ((n0 & 255) >> 7) * 256 + ((n0 >> 8) << 7) + (n0 & 127); }
__device__ __forceinline__ int tok_row(int l, int tt) { return l == 0 ? tt : (tt >> 12) * RPB + CTXL + (tt & 4095); }

__device__ __forceinline__ void ph_prologue(const Ctx& F) {
    unsigned char* ws = KWS();
    float* MOD = (float*)(ws + WS_MOD); float* ROPE = (float*)(ws + WS_ROPE);
    LAS float* sl = (LAS float*)(F.lds);
    LAS float* red = (LAS float*)(F.lds + 40960);
    if ((int)blockIdx.x < 192 || F.G < 192) {
        const float* c_in = KIN(1); const float* cctx_in = KIN(3); const float* ada_w = KIN(4); const float* ada_b = KIN(5);
        for (int i = F.tid; i < 9 * 1024; i += 512) { const int r = i >> 10, k = i & 1023; const float v = r < 8 ? c_in[r * 1024 + k] : cctx_in[k]; sl[i] = v / (1.0f + expf(-v)); }
        __syncthreads();
        for (int grp = blockIdx.x; grp < 192; grp += F.G) {
            const int l = grp / 96, n0 = (grp % 96) * 64;
            const float* W = ada_w + (size_t)l * 1024 * 6144 + n0 + F.lane;
            float acc[9];
#pragma unroll
            for (int r = 0; r < 9; ++r) acc[r] = 0.f;
            const int kb = F.wave * 128;
#pragma unroll 8
            for (int k = 0; k < 128; ++k) { const float w = W[(size_t)(kb + k) * 6144];
#pragma unroll
                for (int r = 0; r < 9; ++r) acc[r] += sl[r * 1024 + kb + k] * w; }
#pragma unroll
            for (int r = 0; r < 9; ++r) red[(F.wave * 9 + r) * 64 + F.lane] = acc[r];
            __syncthreads();
            for (int i = F.tid; i < 576; i += 512) { const int r = i >> 6, ln = i & 63; float s = ada_b[l * 6144 + n0 + ln];
#pragma unroll
                for (int w = 0; w < 8; ++w) s += red[(w * 9 + r) * 64 + ln];
                MOD[(size_t)(l * 9 + r) * 6144 + n0 + ln] = s; }
            __syncthreads();
        }
    }
    __syncthreads();
    for (int idx = blockIdx.x * 512 + F.tid; idx < 4096 * 64; idx += F.G * 512) {
        const int t = idx >> 6, i = idx & 63; const int pos = i < 32 ? (t >> 6) : (t & 63); const int j = i & 31;
        const float freq = powf(10000.0f, -(float)(2 * j) / 64.0f); const float ang = (float)pos * freq;
        ROPE[2 * idx] = cosf(ang); ROPE[2 * idx + 1] = sinf(ang);
    }
    bf16* Wqkv_t = (bf16*)(ws + WS_WQKV); bf16* Wo_t = (bf16*)(ws + WS_WO); bf16* Win_t = (bf16*)(ws + WS_WIN); bf16* Wout_t = (bf16*)(ws + WS_WOUT);
    bf16* Wr_t = (bf16*)(ws + WS_WR); bf16* Wgu_t = (bf16*)(ws + WS_WGU); bf16* Wd_t = (bf16*)(ws + WS_WD);
    LAS float* scr = (LAS float*)(F.lds + F.wave * 16384);
    constexpr int I_QKV = 16 * 48, I_WO = 16 * 32, I_WIN = 16 * 96, I_WOUT = 16 * 32, I_R = 2 * 16 * 8, I_GU = 2 * 256 * 256, I_GUS = 2 * 256, I_D = 2 * 256 * 128, I_DS = 2 * 128;
    constexpr int NITEMS = I_QKV + I_WO + I_WIN + I_WOUT + I_R + I_GU + I_GUS + I_D + I_DS;
    for (int it = F.gw; it < NITEMS; it += F.NGW) {
        int r = it;
        if (r < I_QKV) { const int nblk = 48, kb = r / nblk, nb = r % nblk; transpose_item(KIN(8), 1024, 1536, Wqkv_t, 64 * kb, 32 * nb, 32 * nb, scr, F.lane); continue; } r -= I_QKV;
        if (r < I_WO) { const int nblk = 32, kb = r / nblk, nb = r % nblk; transpose_item(KIN(11), 1024, 1024, Wo_t, 64 * kb, 32 * nb, 32 * nb, scr, F.lane); continue; } r -= I_WO;
        if (r < I_WIN) { const int nblk = 96, kb = r / nblk, nb = r % nblk; transpose_item(KIN(12), 1024, 3072, Win_t, 64 * kb, 32 * nb, 32 * nb, scr, F.lane); continue; } r -= I_WIN;
        if (r < I_WOUT) { const int nblk = 32, kb = r / nblk, nb = r % nblk; transpose_item(KIN(14), 1024, 1024, Wout_t, 64 * kb, 32 * nb, 32 * nb, scr, F.lane); continue; } r -= I_WOUT;
        if (r < I_R) { const int l = r / 128, q = r % 128, kb = q / 8, nb = q % 8; transpose_item(KIN(15) + (size_t)l * 1024 * 256, 1024, 256, Wr_t + (size_t)l * 256 * 1024, 64 * kb, 32 * nb, 32 * nb, scr, F.lane); continue; } r -= I_R;
        if (r < I_GU) { const int mat = r / 256, q = r % 256, kb = q / 16, nb = q % 16, l = mat / 256, e = mat % 256;
            transpose_item(KIN(17) + (size_t)mat * 1024 * 512, 1024, 512, Wgu_t + (size_t)(l * 257 + e) * 512 * 1024, 64 * kb, 32 * nb, gu_row(32 * nb), scr, F.lane); continue; } r -= I_GU;
        if (r < I_GUS) { const int l = r / 256, q = r % 256, kb = q / 16, nb = q % 16;
            transpose_item(KIN(19) + (size_t)l * 1024 * 512, 1024, 512, Wgu_t + (size_t)(l * 257 + 256) * 512 * 1024, 64 * kb, 32 * nb, gu_row(32 * nb), scr, F.lane); continue; } r -= I_GUS;
        if (r < I_D) { const int mat = r / 128, q = r % 128, kb = q / 32, nb = q % 32, l = mat / 256, e = mat % 256;
            transpose_item(KIN(18) + (size_t)mat * 256 * 1024, 256, 1024, Wd_t + (size_t)(l * 257 + e) * 1024 * 256, 64 * kb, 32 * nb, 32 * nb, scr, F.lane); continue; } r -= I_D;
        { const int l = r / 128, q = r % 128, kb = q / 32, nb = q % 32;
            transpose_item(KIN(20) + (size_t)l * 256 * 1024, 256, 1024, Wd_t + (size_t)(l * 257 + 256) * 1024 * 256, 64 * kb, 32 * nb, 32 * nb, scr, F.lane); }
    }
}

__device__ __forceinline__ void ph_modulate0(const Ctx& F) {
    unsigned char* ws = KWS(); const float* MOD = (const float*)(ws + WS_MOD); bf16* HX = (bf16*)(ws + WS_HX);
    const float* x_in = KIN(0); const float* ctx_in = KIN(2);
    for (int m = F.gw; m < MROWS; m += F.NGW) {
        const int b = m / RPB, j = m % RPB;
        const float* src = j < CTXL ? ctx_in + (size_t)(b * CTXL + j) * DM : x_in + (size_t)(b * SEQ + j - CTXL) * DM;
        const float* md = MOD + (size_t)(j < CTXL ? 8 : b) * 6144;
        unsigned long long* o8 = (unsigned long long*)(HX + (size_t)m * DM) + F.lane;
#pragma unroll
        for (int q = 0; q < 4; ++q) { const int c = 4 * F.lane + 256 * q; const f32x4 v = *(const f32x4*)(src + c), sh = *(const f32x4*)(md + c), sc = *(const f32x4*)(md + 1024 + c);
            const f32x4 h = v * (sc + 1.0f) + sh;
            o8[64 * q] = (unsigned long long)cvt_pk_bf16(h[0], h[1]) | ((unsigned long long)cvt_pk_bf16(h[2], h[3]) << 32); }
    }
}

__device__ __forceinline__ void ph_gemm_in(const Ctx& F, int l) {
    unsigned char* ws = KWS();
    const int N = l == 0 ? NQKV : NWIN;
    pg8::DenseOrder S; S.init(l == 0 ? MROWS / 256 : TL1 / 256, N / 256, F.G, (int)blockIdx.x, l, ws + WS_HX, ws + (l == 0 ? WS_WQKV : WS_WIN), DM);
    pg8::EpiBf16 E{(bf16*)(ws + WS_QKV), N};
    pg8::gemm_phase<pg8::EpiBf16, pg8::DenseOrder, false>(F.lds, S, E, DM, F.tid);
}
__device__ __forceinline__ void ph_gemm_out(const Ctx& F, int l) {
    unsigned char* ws = KWS();
    pg8::DenseOrder S; S.init(l == 0 ? MROWS / 256 : TL1 / 256, DM / 256, F.G, (int)blockIdx.x, l, ws + WS_O, ws + (l == 0 ? WS_WO : WS_WOUT), DM);
    pg8::EpiBf16 E{(bf16*)(ws + WS_Y), DM};
    pg8::gemm_phase<pg8::EpiBf16, pg8::DenseOrder, false>(F.lds, S, E, DM, F.tid);
}
__device__ __forceinline__ void ph_router(const Ctx& F, int l) {
    unsigned char* ws = KWS();
    pg8::DenseOrder S; S.init(l == 0 ? MROWS / 256 : TL1 / 256, 1, F.G, (int)blockIdx.x, l, ws + WS_H2, ws + WS_WR + (size_t)l * 256 * 1024 * 2, DM);
    pg8::EpiF32 E{(float*)(ws + WS_LOG), NE};
    pg8::gemm_phase<pg8::EpiF32, pg8::DenseOrder, false>(F.lds, S, E, DM, F.tid);
}

__device__ __forceinline__ void ph_normrope(const Ctx& F, int dry) {
    unsigned char* ws = KWS(); const float* ROPE = (const float*)(ws + WS_ROPE); bf16* QKV = (bf16*)(ws + WS_QKV); bf16* QOUT = dry ? (bf16*)(ws + WS_ACT) : QKV;
    const float* qg = KIN(9); const float* kg = KIN(10);
    const float2 gq = *(const float2*)(qg + 2 * F.lane), gk = *(const float2*)(kg + 2 * F.lane);
    for (int m = F.gw; m < MROWS; m += F.NGW) {
        const int j = m % RPB; const bool lat = j >= CTXL; const int t = j - CTXL;
        float cs = 1.f, sn = 0.f; if (lat) { const float2 r = *(const float2*)(ROPE + 2 * (t * 64 + F.lane)); cs = r.x; sn = r.y; }
        const unsigned* row = (const unsigned*)(QKV + (size_t)m * NQKV); unsigned* orow = (unsigned*)(QOUT + (size_t)m * NQKV);
#pragma unroll
        for (int hh = 0; hh < NH + NKV; ++hh) {
            const unsigned w = row[hh * 64 + F.lane]; const float v0 = bf_lo(w), v1 = bf_hi(w);
            const float ss = wave_sum(v0 * v0 + v1 * v1);
            const float rs = 1.0f / sqrtf(ss * (1.0f / 128.0f) + QK_EPS);
            const float g0 = hh < NH ? gq.x : gk.x, g1 = hh < NH ? gq.y : gk.y;
            const float a0 = v0 * rs * g0, a1 = v1 * rs * g1;
            orow[hh * 64 + F.lane] = cvt_pk_bf16(a0 * cs - a1 * sn, a0 * sn + a1 * cs);
        }
    }
}
__device__ __forceinline__ void ph_conv(const Ctx& F) {
    unsigned char* ws = KWS(); const bf16* QKV = (const bf16*)(ws + WS_QKV); bf16* OB = (bf16*)(ws + WS_O);
    const float* taps = KIN(13);
    for (int tt = F.gw; tt < TL1; tt += F.NGW) {
        const int m = tok_row(1, tt), s = tt & 4095;
        const bf16* r0 = QKV + (size_t)m * NWIN;
        unsigned long long* o8 = (unsigned long long*)(OB + (size_t)m * DM) + F.lane;
#pragma unroll
        for (int q = 0; q < 4; ++q) { const int c = 4 * F.lane + 256 * q;
            const u32x2 bg = *(const u32x2*)(r0 + c);
            f32x4 cv = (f32x4){0.f, 0.f, 0.f, 0.f};
#pragma unroll
            for (int d = -1; d <= 1; ++d) { if (s + d < 0 || s + d >= SEQ) continue;
                const bf16* rr = r0 + (long)d * NWIN; const u32x2 cg = *(const u32x2*)(rr + DM + c), vv = *(const u32x2*)(rr + 2 * DM + c);
                const f32x4 tp = *(const f32x4*)(taps + (d + 1) * DM + c);
                cv[0] += bf_lo(cg.x) * bf_lo(vv.x) * tp[0]; cv[1] += bf_hi(cg.x) * bf_hi(vv.x) * tp[1]; cv[2] += bf_lo(cg.y) * bf_lo(vv.y) * tp[2]; cv[3] += bf_hi(cg.y) * bf_hi(vv.y) * tp[3]; }
            o8[64 * q] = (unsigned long long)cvt_pk_bf16(bf_lo(bg.x) * cv[0], bf_hi(bg.x) * cv[1]) | ((unsigned long long)cvt_pk_bf16(bf_lo(bg.y) * cv[2], bf_hi(bg.y) * cv[3]) << 32); }
    }
}
__device__ __forceinline__ void ph_attention(const Ctx& F, unsigned char* lds_generic) {
    unsigned char* ws = KWS(); const bf16* QKV = (const bf16*)(ws + WS_QKV); bf16* OB = (bf16*)(ws + WS_O);
    for (int L = F.vcu; L < 1024 + 64; L += F.G) {
        int pair, hl, qb;
        if (L < 1024) { pair = (L & 255) / 32 + 8 * ((L >> 8) >> 1); const int u = ((L >> 8) & 1) * 32 + (L & 31); hl = u >> 4; qb = 1 + (u & 15); }
        else { const int s = L - 1024; pair = s >> 2; hl = s & 3; qb = 0; }
        const int b = pair >> 1, kvh = pair & 1, h = kvh * 4 + hl;
        const bf16* base = QKV + (size_t)b * RPB * NQKV;
        __syncthreads();
        att::attn_dense_body(base + (size_t)(qb * 256) * NQKV + h * HD, base + NH * HD + kvh * HD, base + (NH + NKV) * HD + kvh * HD,
                             OB + (size_t)(b * RPB + qb * 256) * DM + h * HD, qb == 0 ? CTXL : RPB, (char*)lds_generic, F.tid);
    }
}
__device__ __forceinline__ void ph_ln1(const Ctx& F, int l) {
    unsigned char* ws = KWS(); const float* md_l = (const float*)(ws + WS_MOD) + (size_t)l * 9 * 6144;
    const bf16* YB = (const bf16*)(ws + WS_Y); float* X1 = (float*)(ws + WS_X1); bf16* H2 = (bf16*)(ws + WS_H2); const float* X2 = (const float*)(ws + WS_X2);
    const float* x_in = KIN(0); const float* ctx_in = KIN(2);
    const float* lg = KIN(6) + (size_t)(l * 2 + 0) * DM; const float* lb = KIN(7) + (size_t)(l * 2 + 0) * DM;
    const int TL = l == 0 ? TL0 : TL1;
    for (int tt = F.gw; tt < TL; tt += F.NGW) {
        const int m = tok_row(l, tt), b = m / RPB, j = m % RPB;
        const float* xr = l == 0 ? (j < CTXL ? ctx_in + (size_t)(b * CTXL + j) * DM : x_in + (size_t)(b * SEQ + j - CTXL) * DM) : X2 + (size_t)m * DM;
        const float* md = md_l + (size_t)(j < CTXL ? 8 : b) * 6144;
        const bf16* yr = YB + (size_t)m * DM;
        f32x4 v[4]; float s = 0.f;
#pragma unroll
        for (int q = 0; q < 4; ++q) { const int c = 4 * F.lane + 256 * q; const f32x4 xv = *(const f32x4*)(xr + c), g = *(const f32x4*)(md + 2 * 1024 + c); const u32x2 yw = *(const u32x2*)(yr + c);
            v[q] = xv * DN_ALPHA + g * (f32x4){bf_lo(yw.x), bf_hi(yw.x), bf_lo(yw.y), bf_hi(yw.y)}; s += (v[q][0] + v[q][1]) + (v[q][2] + v[q][3]); }
        const float mean = wave_sum(s) * (1.f / DM); float s2 = 0.f;
#pragma unroll
        for (int q = 0; q < 4; ++q) { v[q] = v[q] - mean; s2 += (v[q][0] * v[q][0] + v[q][1] * v[q][1]) + (v[q][2] * v[q][2] + v[q][3] * v[q][3]); }
        const float rstd = 1.f / sqrtf(wave_sum(s2) * (1.f / DM) + LN_EPS);
        unsigned long long* o8 = (unsigned long long*)(H2 + (size_t)m * DM) + F.lane;
#pragma unroll
        for (int q = 0; q < 4; ++q) { const int c = 4 * F.lane + 256 * q; const f32x4 o = v[q] * rstd * *(const f32x4*)(lg + c) + *(const f32x4*)(lb + c);
            *(f32x4*)(X1 + (size_t)m * DM + c) = o;
            const f32x4 h = o * (*(const f32x4*)(md + 4 * 1024 + c) + 1.0f) + *(const f32x4*)(md + 3 * 1024 + c);
            o8[64 * q] = (unsigned long long)cvt_pk_bf16(h[0], h[1]) | ((unsigned long long)cvt_pk_bf16(h[2], h[3]) << 32); }
    }
}
__device__ __forceinline__ float sigmoid_f(float x) { return __builtin_amdgcn_rcpf(1.0f + __builtin_amdgcn_exp2f(-1.4426950408889634f * x)); }
__device__ __forceinline__ void ph_routing(const Ctx& F, int l, int dry) {
    unsigned char* ws = KWS(); const float* LOG = (const float*)(ws + WS_LOG); int* EIDX = (int*)(ws + WS_EIDX); float* GATE = (float*)(ws + WS_GATE); int* POS = (int*)(ws + WS_POS);
    unsigned* cnt = (unsigned*)(ws + WS_CTL) + CW_CNT + l * 256;
    const float* rb = KIN(16) + l * NE;
    LAS float* bias = (LAS float*)(F.lds);
    __syncthreads();
    if (F.tid < NE) bias[F.tid] = rb[F.tid];
    __syncthreads();
    const int TL = l == 0 ? TL0 : TL1;
    for (int task = F.wave * F.G + (int)blockIdx.x; task * 64 < TL; task += F.NGW) {
        const int tt = task * 64 + F.lane; const int m = tok_row(l, tt);
        const float* row = LOG + (size_t)m * NE;
        float gsc[8];
#pragma unroll
        for (int g = 0; g < 8; ++g) gsc[g] = 0.f;
#pragma unroll 1
        for (int g = 0; g < 8; ++g) { float a = -INFINITY, b = -INFINITY;
#pragma unroll
            for (int q = 0; q < 8; ++q) { const f32x4 x = *(const f32x4*)(row + g * 32 + q * 4);
#pragma unroll
                for (int j = 0; j < 4; ++j) { const float v = sigmoid_f(x[j]) + bias[g * 32 + q * 4 + j]; const float nb = fmaxf(b, fminf(a, v)); a = fmaxf(a, v); b = nb; } }
            const float gs = a + b;
#pragma unroll
            for (int k = 0; k < 8; ++k) gsc[k] = (g == k) ? gs : gsc[k]; }
        unsigned selmask = 0u;
#pragma unroll
        for (int g = 0; g < 8; ++g) { int rank = 0;
#pragma unroll
            for (int h = 0; h < 8; ++h) rank += (gsc[h] > gsc[g] || (gsc[h] == gsc[g] && h < g)) ? 1 : 0;
            selmask |= (rank < 4 ? 1u : 0u) << g; }
        float lv[8]; int li[8];
#pragma unroll
        for (int s = 0; s < 8; ++s) { lv[s] = -INFINITY; li[s] = 0; }
#pragma unroll 1
        for (int i = 0; i < 4; ++i) { const int g = __builtin_ctz(selmask); selmask &= selmask - 1u;
#pragma unroll
            for (int q = 0; q < 8; ++q) { const f32x4 x = *(const f32x4*)(row + g * 32 + q * 4);
#pragma unroll
                for (int j = 0; j < 4; ++j) { float cv = sigmoid_f(x[j]) + bias[g * 32 + q * 4 + j]; int ci = g * 32 + q * 4 + j;
#pragma unroll
                    for (int s = 0; s < 8; ++s) { const bool gt = cv > lv[s]; const float tv = gt ? lv[s] : cv; const int ti = gt ? li[s] : ci; lv[s] = gt ? cv : lv[s]; li[s] = gt ? ci : li[s]; cv = tv; ci = ti; } } } }
        float sc[8], gsum = 0.f;
#pragma unroll
        for (int s = 0; s < 8; ++s) { sc[s] = sigmoid_f(row[li[s]]); gsum += sc[s]; }
        const float inv = ROUTED_SCALE / gsum;
        int rk[8];
#pragma unroll
        for (int s = 0; s < 8; ++s) rk[s] = (int)atomicAdd(&cnt[li[s]], dry ? 0u : 1u);
        if (!dry) {
#pragma unroll
            for (int s = 0; s < 8; ++s) { EIDX[(size_t)m * 8 + s] = li[s]; GATE[(size_t)m * 8 + s] = sc[s] * inv; POS[(size_t)m * 9 + s] = rk[s]; }
        } else { asm volatile("" :: "v"(rk[0]), "v"(rk[1]), "v"(rk[2]), "v"(rk[3]), "v"(rk[4]), "v"(rk[5]), "v"(rk[6]), "v"(rk[7])); }
    }
}
__device__ __forceinline__ void build_tables(const Ctx& F, int l) {
    unsigned char* ws = KWS(); unsigned* cnt = (unsigned*)(ws + WS_CTL) + CW_CNT + l * 256;
    LAS int* tstart = (LAS int*)(F.lds + TBL_OFF); LAS int* tmp = (LAS int*)(F.lds + TBL_TMP); LAS unsigned short* texp = (LAS unsigned short*)(F.lds + TBL_EXP);
    const int TL = l == 0 ? TL0 : TL1;
    __syncthreads();
    if (F.tid < NE) tmp[F.tid] = ((int)__hip_atomic_load(&cnt[F.tid], __ATOMIC_RELAXED, __HIP_MEMORY_SCOPE_AGENT) + 255) >> 8;
    __syncthreads();
    if (F.tid <= NE) { int s = 0; for (int e = 0; e < F.tid; ++e) s += tmp[e]; tstart[F.tid] = s; }
    __syncthreads();
    const int nrt = tstart[NE];
    if (F.tid < NE) { for (int t = tstart[F.tid]; t < tstart[F.tid + 1]; ++t) texp[t] = (unsigned short)F.tid; }
    for (int t = nrt + F.tid; t < nrt + TL / 256; t += 512) texp[t] = (unsigned short)NE;
    __syncthreads();
}
__device__ __forceinline__ void ph_scatter(const Ctx& F, int l, int dry) {
    unsigned char* ws = KWS(); const int* EIDX = (const int*)(ws + WS_EIDX); int* POS = (int*)(ws + (dry ? WS_ACT : WS_POS)); int* TOK = (int*)(ws + (dry ? WS_ACT + 8 * MiB : WS_TOK)); const int* RNK = (const int*)(ws + WS_POS);
    unsigned* cnt = (unsigned*)(ws + WS_CTL) + CW_CNT + l * 256;
    const LAS int* tstart = (const LAS int*)(F.lds + TBL_OFF);
    const int TL = l == 0 ? TL0 : TL1; const int nrt = tstart[NE];
    for (int idx = blockIdx.x * 512 + F.tid; idx < TL * 8; idx += F.G * 512) {
        const int tt = idx >> 3, k = idx & 7, m = tok_row(l, tt);
        const int e = EIDX[(size_t)m * 8 + k];
        const int p = tstart[e] * 256 + RNK[(size_t)m * 9 + k];
        TOK[p] = m; POS[(size_t)m * 9 + k] = p;
    }
    for (int tt = blockIdx.x * 512 + F.tid; tt < TL; tt += F.G * 512) { const int m = tok_row(l, tt), p = nrt * 256 + tt; TOK[p] = m; POS[(size_t)m * 9 + 8] = p; }
    for (int e = blockIdx.x; e < NE; e += F.G) {
        const int c = (int)__hip_atomic_load(&cnt[e], __ATOMIC_RELAXED, __HIP_MEMORY_SCOPE_AGENT);
        for (int p = tstart[e] * 256 + c + F.tid; p < tstart[e + 1] * 256; p += 512) TOK[p] = tok_row(l, 0);
    }
}
__device__ __forceinline__ void ph_gemm1(const Ctx& F, int l) {
    unsigned char* ws = KWS(); const LAS int* tstart = (const LAS int*)(F.lds + TBL_OFF);
    const int ntiles = tstart[NE] + (l == 0 ? TL0 : TL1) / 256;
    pg8::ExpertOrder<1> S; S.nunits = ntiles * 2; S.G = F.G; S.c = F.vcu; S.texp = (const LAS unsigned short*)(F.lds + TBL_EXP);
    S.A = (const char*)(ws + WS_H2); S.Bt = (const char*)(ws + WS_WGU) + (size_t)l * 257 * 512 * 1024 * 2; S.toks = (const int*)(ws + WS_TOK); S.a_tstep = 0; S.b_tstep = 256u * 1024u * 2u;
    pg8::EpiSwiGLU E{(bf16*)(ws + WS_ACT)};
    pg8::gemm_phase<pg8::EpiSwiGLU, pg8::ExpertOrder<1>, true>(F.lds, S, E, DM, F.tid);
}
__device__ __forceinline__ void ph_gemm2(const Ctx& F, int l) {
    unsigned char* ws = KWS(); const LAS int* tstart = (const LAS int*)(F.lds + TBL_OFF);
    const int ntiles = tstart[NE] + (l == 0 ? TL0 : TL1) / 256;
    pg8::ExpertOrder<2> S; S.nunits = ntiles * 4; S.G = F.G; S.c = F.vcu; S.texp = (const LAS unsigned short*)(F.lds + TBL_EXP);
    S.A = (const char*)(ws + WS_ACT); S.Bt = (const char*)(ws + WS_WD) + (size_t)l * 257 * 1024 * 256 * 2; S.toks = nullptr; S.a_tstep = 256u * EFF * 2u; S.b_tstep = 256u * EFF * 2u;
    pg8::EpiBf16 E{(bf16*)(ws + WS_YS), DM};
    pg8::gemm_phase<pg8::EpiBf16, pg8::ExpertOrder<2>, false>(F.lds, S, E, EFF, F.tid);
}
__device__ __forceinline__ void ph_ln2(const Ctx& F, int l) {
    unsigned char* ws = KWS(); const float* MOD = (const float*)(ws + WS_MOD); const float* md_l = MOD + (size_t)l * 9 * 6144;
    const float* X1 = (const float*)(ws + WS_X1); const bf16* YS = (const bf16*)(ws + WS_YS); const int* POS = (const int*)(ws + WS_POS); const float* GATE = (const float*)(ws + WS_GATE);
    float* X2 = (float*)(ws + WS_X2); bf16* HX = (bf16*)(ws + WS_HX); float* outp = KOUT();
    const float* lg = KIN(6) + (size_t)(l * 2 + 1) * DM; const float* lb = KIN(7) + (size_t)(l * 2 + 1) * DM;
    const int TL = l == 0 ? TL0 : TL1;
    for (int tt = F.gw; tt < TL; tt += F.NGW) {
        const int m = tok_row(l, tt), b = m / RPB, j = m % RPB;
        const float* md = md_l + (size_t)(j < CTXL ? 8 : b) * 6144;
        f32x4 acc[4];
#pragma unroll
        for (int q = 0; q < 4; ++q) acc[q] = (f32x4){0.f, 0.f, 0.f, 0.f};
#pragma unroll
        for (int k = 0; k < 9; ++k) { const int p = POS[(size_t)m * 9 + k]; const float g = k < 8 ? GATE[(size_t)m * 8 + k] : 1.0f; const bf16* yr = YS + (size_t)p * DM;
#pragma unroll
            for (int q = 0; q < 4; ++q) { const u32x2 yw = *(const u32x2*)(yr + 4 * F.lane + 256 * q); acc[q] += (f32x4){bf_lo(yw.x), bf_hi(yw.x), bf_lo(yw.y), bf_hi(yw.y)} * g; } }
        f32x4 v[4]; float s = 0.f;
#pragma unroll
        for (int q = 0; q < 4; ++q) { const int c = 4 * F.lane + 256 * q; const f32x4 xv = *(const f32x4*)(X1 + (size_t)m * DM + c), g = *(const f32x4*)(md + 5 * 1024 + c);
            v[q] = xv * DN_ALPHA + g * acc[q]; s += (v[q][0] + v[q][1]) + (v[q][2] + v[q][3]); }
        const float mean = wave_sum(s) * (1.f / DM); float s2 = 0.f;
#pragma unroll
        for (int q = 0; q < 4; ++q) { v[q] = v[q] - mean; s2 += (v[q][0] * v[q][0] + v[q][1] * v[q][1]) + (v[q][2] * v[q][2] + v[q][3] * v[q][3]); }
        const float rstd = 1.f / sqrtf(wave_sum(s2) * (1.f / DM) + LN_EPS);
        if (l == 0) {
            const float* md1 = MOD + (size_t)(9 + b) * 6144;
            unsigned long long* o8 = (unsigned long long*)(HX + (size_t)m * DM) + F.lane;
#pragma unroll
            for (int q = 0; q < 4; ++q) { const int c = 4 * F.lane + 256 * q; const f32x4 o = v[q] * rstd * *(const f32x4*)(lg + c) + *(const f32x4*)(lb + c);
                *(f32x4*)(X2 + (size_t)m * DM + c) = o;
                if (j >= CTXL) { const f32x4 h = o * (*(const f32x4*)(md1 + 1024 + c) + 1.0f) + *(const f32x4*)(md1 + c);
                    o8[64 * q] = (unsigned long long)cvt_pk_bf16(h[0], h[1]) | ((unsigned long long)cvt_pk_bf16(h[2], h[3]) << 32); } }
        } else {
            float* orow = outp + (size_t)tt * DM;
#pragma unroll
            for (int q = 0; q < 4; ++q) { const int c = 4 * F.lane + 256 * q; *(f32x4*)(orow + c) = v[q] * rstd * *(const f32x4*)(lg + c) + *(const f32x4*)(lb + c); }
        }
    }
}

#ifndef PH_MASK
#define PH_MASK 0xFFFF
#endif
#define EN(i) (((PH_MASK) >> (i)) & 1)
#ifndef REP_MASK
#define REP_MASK 0
#endif
#define REP(i) (((REP_MASK) >> (i)) & 1)
__global__ void __launch_bounds__(512, 2) fwd(Args args) {
    extern __shared__ __attribute__((aligned(16))) unsigned char lds_raw[];
    Ctx F;
    F.lds = (LAS unsigned char*)lds_raw;
    F.tid = threadIdx.x; F.lane = F.tid & 63; F.wave = __builtin_amdgcn_readfirstlane(F.tid >> 6);
    F.G = gridDim.x; { const int bx = blockIdx.x; F.vcu = (F.G % 8 == 0) ? (bx % 8) * (F.G / 8) + bx / 8 : bx; }
    F.gw = blockIdx.x * 8 + F.wave; F.NGW = F.G * 8;
    volatile LAS unsigned* MISC = (volatile LAS unsigned*)(F.lds + MISC_OFF);
    if (F.tid < 64) MISC[F.tid] = 0u;
    __syncthreads();
    const int lo = args.ph_lo, hi = args.ph_hi;
    XcdBarrier bar; bar.bar = (unsigned*)(args.ws + WS_CTL) + CW_BAR; bar.x = 0; bar.st = MISC + 8;
    if (hi - lo > 1) bar = xcd_barrier_post((unsigned*)(args.ws + WS_CTL) + CW_BAR, MISC + 8);
#define IN(k) (lo <= (k) && (k) < hi)
#define SEAM(k) do { if (IN(k) && IN((k) + 1)) xcd_barrier(bar); } while (0)
#define FRESH() asm volatile("" : "+v"(F.tid), "+v"(F.lane))

    if (EN(0) && IN(0)) { FRESH(); _Pragma("nounroll") for (int rep_ = 0; rep_ <= REP(0); ++rep_) { if (rep_ && hi - lo > 1) xcd_barrier(bar); ph_prologue(F); } }
    SEAM(0);
    if (EN(1) && IN(1)) { FRESH(); _Pragma("nounroll") for (int rep_ = 0; rep_ <= REP(1); ++rep_) { if (rep_ && hi - lo > 1) xcd_barrier(bar); ph_modulate0(F); } }
    SEAM(1);
    for (int l = 0; l < 2; ++l) {
        const int P0 = 2 + 11 * l;
        if (EN(2) && IN(P0 + 0)) { FRESH(); _Pragma("nounroll") for (int rep_ = 0; rep_ <= REP(2); ++rep_) { if (rep_ && hi - lo > 1) xcd_barrier(bar); ph_gemm_in(F, l); } }
        SEAM(P0 + 0);
        if (EN(3) && IN(P0 + 1)) { FRESH(); if (l == 0) { _Pragma("nounroll") for (int rep_ = 0; rep_ <= REP(13); ++rep_) { if (rep_ && hi - lo > 1) xcd_barrier(bar); ph_normrope(F, rep_); } } else { _Pragma("nounroll") for (int rep_ = 0; rep_ <= REP(3); ++rep_) { if (rep_ && hi - lo > 1) xcd_barrier(bar); ph_conv(F); } } }
        SEAM(P0 + 1);
        if (l == 0) {
            if (EN(4) && IN(P0 + 2)) { FRESH(); _Pragma("nounroll") for (int rep_ = 0; rep_ <= REP(4); ++rep_) { if (rep_ && hi - lo > 1) xcd_barrier(bar); ph_attention(F, lds_raw); } }
            SEAM(P0 + 2);
        }
        if (EN(5) && IN(P0 + 3)) { FRESH(); _Pragma("nounroll") for (int rep_ = 0; rep_ <= REP(5); ++rep_) { if (rep_ && hi - lo > 1) xcd_barrier(bar); ph_gemm_out(F, l); } }
        SEAM(P0 + 3);
        if (EN(6) && IN(P0 + 4)) { FRESH(); _Pragma("nounroll") for (int rep_ = 0; rep_ <= REP(6); ++rep_) { if (rep_ && hi - lo > 1) xcd_barrier(bar); ph_ln1(F, l); } }
        SEAM(P0 + 4);
        if (EN(7) && IN(P0 + 5)) { FRESH(); _Pragma("nounroll") for (int rep_ = 0; rep_ <= REP(7); ++rep_) { if (rep_ && hi - lo > 1) xcd_barrier(bar); ph_router(F, l); } }
        SEAM(P0 + 5);
        if (EN(8) && IN(P0 + 6)) { FRESH(); _Pragma("nounroll") for (int rep_ = 0; rep_ <= REP(8); ++rep_) { if (rep_ && hi - lo > 1) xcd_barrier(bar); ph_routing(F, l, rep_); } }
        SEAM(P0 + 6);
        if ((EN(9) && IN(P0 + 7)) || (EN(10) && IN(P0 + 8)) || (EN(11) && IN(P0 + 9))) { FRESH(); build_tables(F, l); }
        if (EN(9) && IN(P0 + 7)) { FRESH(); _Pragma("nounroll") for (int rep_ = 0; rep_ <= REP(9); ++rep_) { if (rep_ && hi - lo > 1) xcd_barrier(bar); ph_scatter(F, l, rep_); } }
        SEAM(P0 + 7);
        if (EN(10) && IN(P0 + 8)) { FRESH(); _Pragma("nounroll") for (int rep_ = 0; rep_ <= REP(10); ++rep_) { if (rep_ && hi - lo > 1) xcd_barrier(bar); ph_gemm1(F, l); } }
        SEAM(P0 + 8);
        if (EN(11) && IN(P0 + 9)) { FRESH(); _Pragma("nounroll") for (int rep_ = 0; rep_ <= REP(11); ++rep_) { if (rep_ && hi - lo > 1) xcd_barrier(bar); ph_gemm2(F, l); } }
        SEAM(P0 + 9);
        if (EN(12) && IN(P0 + 10)) { FRESH(); _Pragma("nounroll") for (int rep_ = 0; rep_ <= REP(12); ++rep_) { if (rep_ && hi - lo > 1) xcd_barrier(bar); ph_ln2(F, l); } }
        if (l == 0) SEAM(P0 + 10);
    }
#undef IN
#undef SEAM
}

constexpr int N_PHASES = 2 + 22;
extern "C" void kernel_launch(void* const* d_in, const int* in_sizes, int n_in, void* d_out, int out_size, void* d_ws, size_t ws_size, hipStream_t stream) {
    static int grid = 0;
    if (grid == 0) {
        if (n_in != 21 || out_size != NB * SEQ * DM || ws_size < WS_END) { fprintf(stderr, "kernel_launch: unexpected shapes (n_in %d out %d ws %zu)\n", n_in, out_size, ws_size); grid = -1; return; }
        int dev = 0, cus = 0, per_cu = 0;
        if (hipGetDevice(&dev) != hipSuccess || hipDeviceGetAttribute(&cus, hipDeviceAttributeMultiprocessorCount, dev) != hipSuccess) { grid = -1; return; }
        if (hipFuncSetAttribute((const void*)fwd, hipFuncAttributeMaxDynamicSharedMemorySize, LDS_BYTES) != hipSuccess) { fprintf(stderr, "kernel_launch: hipFuncSetAttribute failed\n"); grid = -1; return; }
        if (hipOccupancyMaxActiveBlocksPerMultiprocessor(&per_cu, (const void*)fwd, 512, LDS_BYTES) != hipSuccess || per_cu < 1) { fprintf(stderr, "kernel_launch: occupancy query says %d\n", per_cu); (void)hipGetLastError(); grid = -1; return; }
        grid = cus;
    }
    if (grid < 0) return;
    (void)hipMemsetAsync((char*)d_ws + WS_CTL, 0, CTL_ZERO_BYTES, stream);
    Args a{};
    for (int i = 0; i < 21; ++i) a.in[i] = (const float*)d_in[i];
    a.out = (float*)d_out; a.ws = (unsigned char*)d_ws;
#if MK_ONE_LAUNCH
    a.ph_lo = 0; a.ph_hi = N_PHASES;
    hipLaunchKernelGGL(fwd, dim3(grid), dim3(512), LDS_BYTES, stream, a);
#else
    for (int p = 0; p < N_PHASES; ++p) {
        if (p == 2 + 11 + 2) continue;
        a.ph_lo = p; a.ph_hi = p + 1;
        hipLaunchKernelGGL(fwd, dim3(grid), dim3(512), LDS_BYTES, stream, a);
    }
#endif
    const hipError_t le = hipPeekAtLastError();
    if (le != hipSuccess) fprintf(stderr, "kernel_launch: launch failed: %s\n", hipGetErrorName(le));
}
```
